# Optimizing an MI355X kernel written in HIP

```python
import jax, jax.numpy as jnp
from jax import lax
import numpy as np

D_MODEL = 1024
BATCH = 32
SEQ = 256
DEPTH = 1
DEC_BATCH = 8
DEC_SEQ = 1024
PAST_LEN = 256

GRID_W = 64
D_MIX = D_MODEL
HG_HEADS = 4
HG_DK = D_MIX // 8
HG_DV = D_MIX // 8
HG_W = HG_HEADS * HG_DK
RG_W = D_MIX - HG_W
RG_HEADS = 8
RG_BW = RG_W // RG_HEADS
RG_C = 8.0
CONV_W = 4
CONV_PAD = (CONV_W // 2, CONV_W - 1 - CONV_W // 2)
CHUNK = 32
D_IN = 5 * HG_W + 2 * RG_W
SPLITS = [HG_W, 2 * HG_W, 3 * HG_W, 4 * HG_W, 5 * HG_W, 5 * HG_W + RG_W]
PEER_HEADS = 8
PEER_NKEYS = 128
PEER_EXPERTS = PEER_NKEYS * PEER_NKEYS
PEER_TOPK = 16
PEER_DQ = 256
PEER_BLOCK = 128
ALPHA = (2.0 * DEPTH) ** 0.25
BETA = (8.0 * DEPTH) ** -0.25
LN_EPS = 1e-5
RMS_EPS = 1e-6

kernel_name = 'hymba_hgrn2_rglru_peer_diffusion_step'

F32 = jnp.float32


def _layer_norm(x, g, b):
    xf = x.astype(F32)
    mu = jnp.mean(xf, -1, keepdims=True)
    var = jnp.mean(jnp.square(xf - mu), -1, keepdims=True)
    return ((xf - mu) * lax.rsqrt(var + LN_EPS) * g.astype(F32) + b.astype(F32)).astype(x.dtype)


def _dwconv(x, w, b):
    y = lax.conv_general_dilated(x, w[:, None, :].astype(x.dtype), (1,), [CONV_PAD],
                                 dimension_numbers=('NWC', 'WIO', 'NWC'),
                                 feature_group_count=x.shape[-1])
    return y + b.astype(x.dtype)


def _hgrn2_chunk(q, k, v, log_f, s0):
    bsz, t, nh, _ = q.shape
    dv = v.shape[-1]
    nc = t // CHUNK

    def ch(a):
        return a.reshape(bsz, nc, CHUNK, nh, a.shape[-1])
    q, k, v, log_f = ch(q), ch(k), ch(v), ch(log_f)
    b = jnp.cumsum(log_f, axis=2)
    b_last = b[:, :, -1:]
    q_dec = q * jnp.exp(b)
    k_dec = k * jnp.exp(-b)
    k_end = k * jnp.exp(b_last - b)
    mask = jnp.tril(jnp.ones((CHUNK, CHUNK), dtype=bool))
    att = jnp.where(mask, jnp.einsum('bnchd,bnshd->bnhcs', q_dec, k_dec), 0.0)
    o_intra = jnp.einsum('bnhcs,bnshe->bnche', att, v)
    d_state = jnp.einsum('bnchd,bnche->nbhde', k_end, v)
    decay = jnp.moveaxis(jnp.exp(b_last[:, :, 0]), 1, 0)

    def step(s, inp):
        g_n, ds_n = inp
        return g_n[..., None] * s + ds_n, s
    s_final, s_prev = lax.scan(step, s0, (decay, d_state))
    o_inter = jnp.einsum('bnchd,nbhde->bnche', q_dec, s_prev)
    return (o_intra + o_inter).reshape(bsz, t, nh, dv), s_final


def _hgrn2_bidir(q, v, f_pre, g, lb, norm_g, s0):
    bsz, t, _ = q.shape

    def heads(a):
        return a.astype(F32).reshape(bsz, t, HG_HEADS, -1)
    qh = heads(jax.nn.silu(q))
    vh = heads(v)
    outs, states = [], []
    for d in range(2):
        z = f_pre[d].astype(F32)
        f = lb[d] + (1.0 - lb[d]) * jax.nn.sigmoid(z)
        k = (1.0 - lb[d]) * jax.nn.sigmoid(-z)
        args = (qh, heads(k), vh, jnp.log(heads(f)))
        if d == 1:
            args = tuple(jnp.flip(a, axis=1) for a in args)
        od, sd = _hgrn2_chunk(*args, s0[:, d].astype(F32))
        outs.append(od if d == 0 else jnp.flip(od, axis=1))
        states.append(sd)
    o = outs[0] + outs[1]
    o = o * lax.rsqrt(jnp.mean(o * o, -1, keepdims=True) + RMS_EPS) * norm_g.astype(F32).reshape(HG_HEADS, HG_DV)
    o = o.reshape(bsz, t, HG_W).astype(g.dtype) * jax.nn.silu(g)
    return o, jnp.stack(states, axis=1)


def _lin_comb(left, right):
    a1, u1 = left
    a2, u2 = right
    return a1 * a2, a2 * u1 + u2


def _rglru(x, w_r, b_r, w_i, b_i, lam, h0):
    bsz, t, _ = x.shape
    xb = x.reshape(bsz, t, RG_HEADS, RG_BW)

    def gate(w, b):
        return jax.nn.sigmoid(jnp.einsum('btnc,ncd->btnd', xb, w.astype(F32)).reshape(bsz, t, RG_W) + b.astype(F32))
    r = gate(w_r, b_r)
    i = gate(w_i, b_i)
    log_a = -RG_C * r * jax.nn.softplus(-lam.astype(F32))
    a = jnp.exp(log_a)
    u = jnp.sqrt(-jnp.expm1(2.0 * log_a)) * (i * x)
    a_cum, h = lax.associative_scan(_lin_comb, (a, u), axis=1)
    h = h + a_cum * h0[:, None, :]
    return h, h[:, -1]


def _rglru_bidir(x, lp, h0):
    x = x.astype(F32)
    hs, states = [], []
    for d in range(2):
        xd = x if d == 0 else jnp.flip(x, axis=1)
        h, hl = _rglru(xd, lp['rg_wr'][d], lp['rg_br'][d], lp['rg_wi'][d], lp['rg_bi'][d],
                       lp['rg_lam'][d], h0[:, d].astype(F32))
        hs.append(h if d == 0 else jnp.flip(h, axis=1))
        states.append(hl)
    return hs[0] + hs[1], jnp.stack(states, axis=1)


def _token_mixer(h, s_hg0, s_rg0, grid, lp):
    bsz, t, _ = h.shape
    z = h @ lp['w_in']
    q, iv, f_f, f_b, g, xr, gr = jnp.split(z, SPLITS, axis=-1)
    o_hg, s_hg = _hgrn2_bidir(q, iv, (f_f, f_b), g, lp['lb'], lp['hg_norm'], s_hg0)
    if grid:
        rows = t // GRID_W
        xr = xr.reshape(bsz, rows, GRID_W, RG_W).transpose(0, 2, 1, 3)
        xc = _dwconv(xr.reshape(bsz * GRID_W, rows, RG_W), lp['conv_w'], lp['conv_b'])
        xc = xc.reshape(bsz, GRID_W * rows, RG_W)
    else:
        xc = _dwconv(xr, lp['conv_w'], lp['conv_b'])
    hr, s_rg = _rglru_bidir(xc, lp, s_rg0)
    if grid:
        hr = hr.reshape(bsz, GRID_W, rows, RG_W).transpose(0, 2, 1, 3).reshape(bsz, t, RG_W)
    y_rg = hr.astype(h.dtype) * jax.nn.gelu(gr)
    out = jnp.concatenate([o_hg.astype(h.dtype), y_rg], axis=-1) @ lp['w_out']
    return out, s_hg, s_rg


def _peer(h, wq, keys, u_tab, v_tab):
    bsz, t, d = h.shape
    blocks = h.reshape(-1, PEER_BLOCK, d)

    def blk(xb):
        m = xb.shape[0]
        q = (xb @ wq).reshape(m, PEER_HEADS, 2, PEER_DQ // 2)
        s = jnp.einsum('mhpd,hpkd->mhpk', q, keys)
        sv, si = lax.top_k(s, PEER_TOPK)
        cand = (sv[:, :, 0, :, None] + sv[:, :, 1, None, :]).reshape(m, PEER_HEADS, PEER_TOPK * PEER_TOPK)
        cand_idx = (si[:, :, 0, :, None] * PEER_NKEYS + si[:, :, 1, None, :]).reshape(m, PEER_HEADS, PEER_TOPK * PEER_TOPK)
        fv, fi = lax.top_k(cand, PEER_TOPK)
        idx = jnp.take_along_axis(cand_idx, fi, axis=-1)
        gate = jax.nn.softmax(fv.astype(F32), axis=-1).astype(xb.dtype)
        act = jax.nn.gelu(jnp.einsum('md,mhkd->mhk', xb, u_tab[idx]))
        return jnp.einsum('mhk,mhkd->md', gate * act, v_tab[idx])
    return lax.map(blk, blocks).reshape(bsz, t, d)


def _layer(x, cond, s_hg0, s_rg0, grid, lp):
    mod = jax.nn.silu(cond) @ lp['w_ada'] + lp['b_ada']
    sh1, sc1, g1, sh2, sc2, g2 = jnp.split(mod[:, None, :], 6, axis=-1)
    h = x * (1.0 + sc1) + sh1
    mix, s_hg, s_rg = _token_mixer(h, s_hg0, s_rg0, grid, lp)
    x = _layer_norm(ALPHA * x + g1 * mix, lp['ln1_g'], lp['ln1_b'])
    h = x * (1.0 + sc2) + sh2
    ff = _peer(h, lp['peer_wq'], lp['peer_keys'], lp['peer_u'], lp['peer_v'])
    x = _layer_norm(ALPHA * x + g2 * ff, lp['ln2_g'], lp['ln2_b'])
    return x, s_hg, s_rg


def setup_inputs(seed: int = 0) -> dict:
    key = jax.random.key(seed)
    ks = iter(jax.random.split(key, 40))

    def nrm(shape, scale):
        return jax.random.normal(next(ks), shape, F32) * scale
    u = jax.random.uniform(next(ks), (DEPTH, 2, RG_W), F32, minval=0.9, maxval=0.999)
    s = u ** (1.0 / RG_C)
    rg_lam = jnp.log(s) - jnp.log1p(-s)
    return {
        'x_prompt': nrm((BATCH, SEQ, D_MODEL), 1.0),
        'x_sample': nrm((DEC_BATCH, DEC_SEQ, D_MODEL), 1.0),
        'c': nrm((DEC_BATCH, D_MODEL), 1.0),
        'state_hgrn': nrm((DEC_BATCH, DEPTH, 2, HG_HEADS, HG_DK, HG_DV), 0.3),
        'state_rglru': nrm((DEC_BATCH, DEPTH, 2, RG_W), 0.5),
        'c_ctx': nrm((D_MODEL,), 1.0),
        'w_ada': nrm((DEPTH, D_MODEL, 6 * D_MODEL), 0.3 * D_MODEL ** -0.5),
        'b_ada': nrm((DEPTH, 6 * D_MODEL), 0.02),
        'w_in': nrm((DEPTH, D_MODEL, D_IN), D_MODEL ** -0.5),
        'hgrn_lb': nrm((2, DEPTH + 1, HG_W), 0.1),
        'hgrn_norm_g': 1.0 + nrm((DEPTH, HG_W), 0.02),
        'conv_w': nrm((DEPTH, CONV_W, RG_W), CONV_W ** -0.5),
        'conv_b': nrm((DEPTH, RG_W), 0.02),
        'rg_wr': nrm((DEPTH, 2, RG_HEADS, RG_BW, RG_BW), RG_BW ** -0.5),
        'rg_br': nrm((DEPTH, 2, RG_W), 0.02),
        'rg_wi': nrm((DEPTH, 2, RG_HEADS, RG_BW, RG_BW), RG_BW ** -0.5),
        'rg_bi': nrm((DEPTH, 2, RG_W), 0.02),
        'rg_lam': rg_lam,
        'w_out': nrm((DEPTH, D_MIX, D_MODEL), BETA * D_MIX ** -0.5),
        'ln1_g': 1.0 + nrm((DEPTH, D_MODEL), 0.02),
        'ln1_b': nrm((DEPTH, D_MODEL), 0.02),
        'peer_wq': nrm((DEPTH, D_MODEL, PEER_HEADS * PEER_DQ), D_MODEL ** -0.5),
        'peer_keys': nrm((DEPTH, PEER_HEADS, 2, PEER_NKEYS, PEER_DQ // 2), (PEER_DQ // 2) ** -0.5),
        'peer_u': nrm((DEPTH, PEER_EXPERTS, D_MODEL), D_MODEL ** -0.5),
        'peer_v': nrm((DEPTH, PEER_EXPERTS, D_MODEL), BETA),
        'ln2_g': 1.0 + nrm((DEPTH, D_MODEL), 0.02),
        'ln2_b': nrm((DEPTH, D_MODEL), 0.02),
    }


def reference(x_prompt, x_sample, c, state_hgrn, state_rglru, c_ctx, w_ada, b_ada, w_in,
              hgrn_lb, hgrn_norm_g, conv_w, conv_b, rg_wr, rg_br, rg_wi, rg_bi, rg_lam,
              w_out, ln1_g, ln1_b, peer_wq, peer_keys, peer_u, peer_v, ln2_g, ln2_b):
    lb_all = jnp.cumsum(jax.nn.softmax(hgrn_lb.astype(F32), axis=1), axis=1)
    xp, xs = x_prompt, x_sample
    bp = x_prompt.shape[0]
    new_hg, new_rg = [], []
    for l in range(DEPTH):
        lp = {
            'w_ada': w_ada[l], 'b_ada': b_ada[l], 'w_in': w_in[l], 'lb': lb_all[:, l],
            'hg_norm': hgrn_norm_g[l], 'conv_w': conv_w[l], 'conv_b': conv_b[l],
            'rg_wr': rg_wr[l], 'rg_br': rg_br[l], 'rg_wi': rg_wi[l], 'rg_bi': rg_bi[l],
            'rg_lam': rg_lam[l], 'w_out': w_out[l], 'ln1_g': ln1_g[l], 'ln1_b': ln1_b[l],
            'peer_wq': peer_wq[l], 'peer_keys': peer_keys[l], 'peer_u': peer_u[l],
            'peer_v': peer_v[l], 'ln2_g': ln2_g[l], 'ln2_b': ln2_b[l],
        }
        zero_hg = jnp.zeros((bp, 2, HG_HEADS, HG_DK, HG_DV), F32)
        zero_rg = jnp.zeros((bp, 2, RG_W), F32)
        xp, s_hg, s_rg = _layer(xp, c_ctx[None, :], zero_hg, zero_rg, False, lp)
        new_hg.append(s_hg)
        new_rg.append(s_rg)
        xs, _, _ = _layer(xs, c, state_hgrn[:, l], state_rglru[:, l], True, lp)
    new_state_hgrn = jnp.stack(new_hg, axis=1).astype(x_prompt.dtype)
    new_state_rglru = jnp.stack(new_rg, axis=1).astype(x_prompt.dtype)
    return (xp, xs, new_state_hgrn, new_state_rglru)
```

```cpp
#include <hip/hip_runtime.h>
#include <hip/hip_bf16.h>
#include <hip/hip_fp16.h>
#include <cstdint>
#include <cstdio>

constexpr int DM = 1024;
constexpr int NTOK = 16384;
constexpr int NCTX_TOK = 8192;
constexpr int NSEQ = 40;
constexpr int DIN = 3584;
constexpr int HGW = 512, RGW = 512;
constexpr float ALPHA_C = 1.189207115002721f;
constexpr float LN_EPS = 1e-5f, RMS_EPS = 1e-6f;
constexpr size_t MB = 1u << 20;
constexpr size_t OFF_MOD = 0, OFF_LB = 256 << 10, OFF_STATS = 512 << 10;
constexpr size_t OFF_SQ = 16 * MB, OFF_VV = 32 * MB, OFF_MIX = 16 * MB;
constexpr size_t OFF_SG = 48 * MB, OFF_GGR = 64 * MB;
constexpr size_t OFF_LOGF = 80 * MB  , OFF_VBUF = 80 * MB;
constexpr size_t OFF_XR = 144 * MB, OFF_IDX = 144 * MB  , OFF_GATE = 152 * MB;
constexpr size_t OFF_HF = 176 * MB  ;
constexpr size_t OUT_STHG = 16777216, OUT_STRG = 20971520;

typedef unsigned short u16;
__device__ __forceinline__ float bf2f(u16 v) { return __uint_as_float(((unsigned)v) << 16); }
__device__ __forceinline__ u16 f2bf(float f) { unsigned u = __float_as_uint(f); u += 0x7FFFu + ((u >> 16) & 1u); return (u16)(u >> 16); }
__device__ __forceinline__ float sigmoidf_(float x) { return 1.0f / (1.0f + expf(-x)); }
__device__ __forceinline__ float siluf_(float x) { return x / (1.0f + expf(-x)); }
__device__ __forceinline__ float geluf_(float x) { return 0.5f * x * (1.0f + tanhf(0.7978845608028654f * (x + 0.044715f * x * x * x))); }
__device__ __forceinline__ float softplusf_(float x) { return fmaxf(x, 0.f) + log1pf(expf(-fabsf(x))); }

__device__ __forceinline__ int seq_of_tok(int t) { return t < NCTX_TOK ? (t >> 8) : 32 + ((t - NCTX_TOK) >> 10); }
__device__ __forceinline__ int cond_of_tok(int t) { return t < NCTX_TOK ? 0 : 1 + ((t - NCTX_TOK) >> 10); }

struct P {
    const float *x_prompt, *x_sample, *c, *state_hgrn, *state_rglru, *c_ctx, *w_ada, *b_ada, *w_in, *hgrn_lb, *hgrn_norm_g, *conv_w, *conv_b,
        *rg_wr, *rg_br, *rg_wi, *rg_bi, *rg_lam, *w_out, *ln1_g, *ln1_b, *peer_wq, *peer_keys, *peer_u, *peer_v, *ln2_g, *ln2_b;
    float* out; char* ws;
};
__device__ __forceinline__ const float* xrow(const P& p, int t) { return t < NCTX_TOK ? p.x_prompt + (size_t)t * DM : p.x_sample + (size_t)(t - NCTX_TOK) * DM; }

__global__ void k_mod(P p) {
    float* mod = (float*)(p.ws + OFF_MOD);
    int j = blockIdx.x * 256 + threadIdx.x;
    int r = blockIdx.y;
    const float* cond = r == 0 ? p.c_ctx : p.c + (size_t)(r - 1) * DM;
    float acc = 0.f;
    for (int k = 0; k < DM; ++k) acc += siluf_(cond[k]) * p.w_ada[(size_t)k * 6144 + j];
    mod[r * 6144 + j] = acc + p.b_ada[j];
    if (blockIdx.x == 0 && r == 0) {
        float* lb = (float*)(p.ws + OFF_LB);
        for (int i = threadIdx.x; i < 1024; i += 256) {
            int d = i >> 9, ch = i & 511;
            float l0 = p.hgrn_lb[(d * 2 + 0) * 512 + ch], l1 = p.hgrn_lb[(d * 2 + 1) * 512 + ch];
            float m = fmaxf(l0, l1); float e0 = expf(l0 - m), e1 = expf(l1 - m);
            lb[i] = e0 / (e0 + e1);
        }
    }
}

template <class AF, class BF, class EPI>
__global__ void __launch_bounds__(256) k_sgemm(P p, int K) {
    AF af; BF bf; EPI epi;
    __shared__ float As[16][68];
    __shared__ float Bs[16][68];
    const int t = threadIdx.x, tx = t & 15, ty = t >> 4;
    const int row0 = blockIdx.y * 64, col0 = blockIdx.x * 64;
    float acc[4][4];
#pragma unroll
    for (int i = 0; i < 4; ++i)
#pragma unroll
        for (int j = 0; j < 4; ++j) acc[i][j] = 0.f;
    for (int k0 = 0; k0 < K; k0 += 16) {
#pragma unroll
        for (int i = 0; i < 4; ++i) {
            int idx = t + 256 * i;
            int m = idx >> 4, k = idx & 15;
            As[k][m] = af(p, row0 + m, k0 + k);
            int kk = idx >> 6, n = idx & 63;
            Bs[kk][n] = bf(p, k0 + kk, col0 + n);
        }
        __syncthreads();
#pragma unroll
        for (int k = 0; k < 16; ++k) {
            float a[4], b[4];
#pragma unroll
            for (int i = 0; i < 4; ++i) { a[i] = As[k][ty * 4 + i]; b[i] = Bs[k][tx * 4 + i]; }
#pragma unroll
            for (int i = 0; i < 4; ++i)
#pragma unroll
                for (int j = 0; j < 4; ++j) acc[i][j] += a[i] * b[j];
        }
        __syncthreads();
    }
#pragma unroll
    for (int i = 0; i < 4; ++i)
#pragma unroll
        for (int j = 0; j < 4; ++j) epi(p, row0 + ty * 4 + i, col0 + tx * 4 + j, acc[i][j]);
}

struct AF1 { __device__ float operator()(const P& p, int t, int k) const {
    const float* mod = (const float*)(p.ws + OFF_MOD) + cond_of_tok(t) * 6144;
    return xrow(p, t)[k] * (1.f + mod[1024 + k]) + mod[k]; } };
struct BF1 { __device__ float operator()(const P& p, int k, int n) const { return p.w_in[(size_t)k * DIN + n]; } };
struct EPI1 { __device__ void operator()(const P& p, int t, int n, float z) const {
    const int part = n >> 9, c = n & 511; const size_t o = (size_t)t * 512 + c;
    const float* lb = (const float*)(p.ws + OFF_LB);
    if (part == 0) ((u16*)(p.ws + OFF_SQ))[o] = f2bf(siluf_(z));
    else if (part == 1) ((u16*)(p.ws + OFF_VV))[o] = f2bf(z);
    else if (part == 2) { float l = lb[c]; ((float*)(p.ws + OFF_LOGF))[o] = logf(l + (1.f - l) * sigmoidf_(z)); }
    else if (part == 3) { float l = lb[512 + c]; ((float*)(p.ws + OFF_LOGF + 32 * MB))[o] = logf(l + (1.f - l) * sigmoidf_(z)); }
    else if (part == 4) ((u16*)(p.ws + OFF_SG))[o] = f2bf(siluf_(z));
    else if (part == 5) ((float*)(p.ws + OFF_XR))[o] = z;
    else ((u16*)(p.ws + OFF_GGR))[o] = f2bf(geluf_(z)); } };

struct AF3 { __device__ float operator()(const P& p, int t, int k) const { return bf2f(((const u16*)(p.ws + OFF_MIX))[(size_t)t * DM + k]); } };
struct BF3 { __device__ float operator()(const P& p, int k, int n) const { return p.w_out[(size_t)k * DM + n]; } };
struct EPI3 { __device__ void operator()(const P& p, int t, int n, float a) const {
    const float* mod = (const float*)(p.ws + OFF_MOD) + cond_of_tok(t) * 6144;
    ((float*)(p.ws + OFF_VBUF))[(size_t)t * DM + n] = ALPHA_C * xrow(p, t)[n] + mod[2048 + n] * a; } };

__device__ __forceinline__ float x1_of(const P& p, int t, int k) {
    const float* st = (const float*)(p.ws + OFF_STATS) + 2 * t;
    return (((const float*)(p.ws + OFF_VBUF))[(size_t)t * DM + k] - st[0]) * st[1] * p.ln1_g[k] + p.ln1_b[k];
}
struct AF4 { __device__ float operator()(const P& p, int t, int k) const {
    const float* mod = (const float*)(p.ws + OFF_MOD) + cond_of_tok(t) * 6144;
    return x1_of(p, t, k) * (1.f + mod[4096 + k]) + mod[3072 + k]; } };
struct BF4 { __device__ float operator()(const P& p, int k, int n) const { return p.peer_wq[(size_t)k * 2048 + n]; } };
struct EPI4 { __device__ void operator()(const P& p, int t, int n, float a) const { ((__half*)p.out)[(size_t)t * 2048 + n] = __float2half(a); } };

__global__ void __launch_bounds__(256) k_hgrn(P p) {
    const int item = blockIdx.x;
    const int dir = item & 1, head = (item >> 1) & 3, seq = item >> 3;
    const int T = seq < 32 ? 256 : 1024;
    const int tok0 = seq < 32 ? seq * 256 : NCTX_TOK + (seq - 32) * 1024;
    const int t = threadIdx.x, e = t & 127, dh = t >> 7;
    __shared__ float fq[8][128], fk[8][128], ff[8][128], fv[8][128], po[8][128];
    const u16* sq = (const u16*)(p.ws + OFF_SQ);
    const u16* vv = (const u16*)(p.ws + OFF_VV);
    const float* lg = (const float*)(p.ws + OFF_LOGF + (size_t)dir * 32 * MB);
    float* od = p.out + (size_t)dir * 8388608;
    float S[64];
    if (seq >= 32) {
        const float* s0 = p.state_hgrn + ((size_t)((seq - 32) * 2 + dir) * 4 + head) * 16384;
#pragma unroll
        for (int i = 0; i < 64; ++i) S[i] = s0[(dh * 64 + i) * 128 + e];
    } else {
#pragma unroll
        for (int i = 0; i < 64; ++i) S[i] = 0.f;
    }
    for (int s0i = 0; s0i < T; s0i += 8) {
        {
            const int st = t >> 5, c4 = (t & 31) * 4;
            const int sidx = s0i + st;
            const int tok = tok0 + (dir ? T - 1 - sidx : sidx);
            const size_t o = (size_t)tok * 512 + head * 128 + c4;
#pragma unroll
            for (int j = 0; j < 4; ++j) {
                float f = expf(lg[o + j]);
                ff[st][c4 + j] = f; fk[st][c4 + j] = 1.f - f;
                fq[st][c4 + j] = bf2f(sq[o + j]); fv[st][c4 + j] = bf2f(vv[o + j]);
            }
        }
        __syncthreads();
        float acc[8];
#pragma unroll
        for (int st = 0; st < 8; ++st) {
            const float ve = fv[st][e];
            float a = 0.f;
#pragma unroll
            for (int i = 0; i < 64; ++i) {
                const int d = dh * 64 + i;
                S[i] = ff[st][d] * S[i] + fk[st][d] * ve;
                a += fq[st][d] * S[i];
            }
            acc[st] = a;
        }
        if (dh == 1) {
#pragma unroll
            for (int st = 0; st < 8; ++st) po[st][e] = acc[st];
        }
        __syncthreads();
        if (dh == 0) {
#pragma unroll
            for (int st = 0; st < 8; ++st) {
                const int sidx = s0i + st;
                const int tok = tok0 + (dir ? T - 1 - sidx : sidx);
                od[(size_t)tok * 512 + head * 128 + e] = acc[st] + po[st][e];
            }
        }
    }
    if (seq < 32) {
        float* so = p.out + OUT_STHG + ((size_t)(seq * 2 + dir) * 4 + head) * 16384;
#pragma unroll
        for (int i = 0; i < 64; ++i) so[(dh * 64 + i) * 128 + e] = S[i];
    }
}

__device__ __forceinline__ int rg_tok(int seq, int s) {
    if (seq < 32) return seq * 256 + s;
    const int col = s >> 4, row = s & 15;
    return NCTX_TOK + (seq - 32) * 1024 + row * 64 + col;
}
__global__ void __launch_bounds__(64) k_rg(P p) {
    const int item = blockIdx.x;
    const int blk = item & 7, dir = (item >> 3) & 1, seq = item >> 4;
    const int T = seq < 32 ? 256 : 1024;
    const int ch = threadIdx.x, gch = blk * 64 + ch;
    const float* xr = (const float*)(p.ws + OFF_XR);
    float* hd = (float*)(p.ws + OFF_HF + (size_t)dir * 32 * MB);
    __shared__ float xc[8][64];
    float wr[64], wi[64];
    const float* Wr = p.rg_wr + ((size_t)(dir * 8 + blk) * 64) * 64;
    const float* Wi = p.rg_wi + ((size_t)(dir * 8 + blk) * 64) * 64;
#pragma unroll
    for (int c = 0; c < 64; ++c) { wr[c] = Wr[c * 64 + ch]; wi[c] = Wi[c * 64 + ch]; }
    const float br = p.rg_br[dir * 512 + gch], bi = p.rg_bi[dir * 512 + gch];
    const float spl = softplusf_(-p.rg_lam[dir * 512 + gch]);
    const float cw0 = p.conv_w[0 * 512 + gch], cw1 = p.conv_w[1 * 512 + gch], cw2 = p.conv_w[2 * 512 + gch], cw3 = p.conv_w[3 * 512 + gch];
    const float cb = p.conv_b[gch];
    float h = seq >= 32 ? p.state_rglru[(size_t)((seq - 32) * 2 + dir) * 512 + gch] : 0.f;
    for (int s0 = 0; s0 < T; s0 += 8) {
        float myx[8];
#pragma unroll
        for (int st = 0; st < 8; ++st) {
            const int sp = s0 + st;
            const int s = dir ? T - 1 - sp : sp;
            float v = cb;
            const int lo = seq < 32 ? 0 : (s & ~15), hi = seq < 32 ? T : (s & ~15) + 16;
            const float cw[4] = {cw0, cw1, cw2, cw3};
#pragma unroll
            for (int j = 0; j < 4; ++j) {
                const int ss = s + j - 2;
                if (ss >= lo && ss < hi) v += cw[j] * xr[(size_t)rg_tok(seq, ss) * 512 + gch];
            }
            myx[st] = v; xc[st][ch] = v;
        }
        __syncthreads();
#pragma unroll
        for (int st = 0; st < 8; ++st) {
            float gr_ = br, gi_ = bi;
#pragma unroll
            for (int c = 0; c < 64; ++c) { const float xv = xc[st][c]; gr_ += xv * wr[c]; gi_ += xv * wi[c]; }
            const float r = sigmoidf_(gr_), ig = sigmoidf_(gi_);
            const float log_a = -8.0f * r * spl;
            const float a = expf(log_a);
            const float u = sqrtf(-expm1f(2.0f * log_a)) * (ig * myx[st]);
            h = a * h + u;
            const int sp = s0 + st; const int s = dir ? T - 1 - sp : sp;
            hd[(size_t)rg_tok(seq, s) * 512 + gch] = h;
        }
        __syncthreads();
    }
    if (seq < 32) p.out[OUT_STRG + (size_t)(seq * 2 + dir) * 512 + gch] = h;
}

__global__ void __launch_bounds__(256) k_combine(P p) {
    const int tok = blockIdx.x * 4 + (threadIdx.x >> 6), lane = threadIdx.x & 63;
    const float* of = p.out + (size_t)tok * 512; const float* ob = p.out + 8388608 + (size_t)tok * 512;
    const u16* sg = (const u16*)(p.ws + OFF_SG) + (size_t)tok * 512;
    const u16* ggr = (const u16*)(p.ws + OFF_GGR) + (size_t)tok * 512;
    const float* hf = (const float*)(p.ws + OFF_HF) + (size_t)tok * 512; const float* hb = (const float*)(p.ws + OFF_HF + 32 * MB) + (size_t)tok * 512;
    u16* mix = (u16*)(p.ws + OFF_MIX) + (size_t)tok * DM;
    float o[8]; float ss = 0.f;
#pragma unroll
    for (int j = 0; j < 8; ++j) { o[j] = of[lane * 8 + j] + ob[lane * 8 + j]; ss += o[j] * o[j]; }
    ss += __shfl_xor(ss, 1); ss += __shfl_xor(ss, 2); ss += __shfl_xor(ss, 4); ss += __shfl_xor(ss, 8);
    const float rs = rsqrtf(ss * (1.f / 128.f) + RMS_EPS);
#pragma unroll
    for (int j = 0; j < 8; ++j) { const int c = lane * 8 + j; mix[c] = f2bf(o[j] * rs * p.hgrn_norm_g[c] * bf2f(sg[c])); }
#pragma unroll
    for (int j = 0; j < 8; ++j) { const int c = lane * 8 + j; mix[512 + c] = f2bf((hf[c] + hb[c]) * bf2f(ggr[c])); }
}

__global__ void __launch_bounds__(256) k_ln1stats(P p) {
    const int tok = blockIdx.x * 4 + (threadIdx.x >> 6), lane = threadIdx.x & 63;
    const float* v = (const float*)(p.ws + OFF_VBUF) + (size_t)tok * DM;
    float x[16]; float s = 0.f;
#pragma unroll
    for (int j = 0; j < 16; ++j) { x[j] = v[j * 64 + lane]; s += x[j]; }
#pragma unroll
    for (int m = 1; m < 64; m <<= 1) s += __shfl_xor(s, m);
    const float mu = s * (1.f / 1024.f); float q = 0.f;
#pragma unroll
    for (int j = 0; j < 16; ++j) { const float d = x[j] - mu; q += d * d; }
#pragma unroll
    for (int m = 1; m < 64; m <<= 1) q += __shfl_xor(q, m);
    if (lane == 0) { float* st = (float*)(p.ws + OFF_STATS) + 2 * tok; st[0] = mu; st[1] = rsqrtf(q * (1.f / 1024.f) + LN_EPS); }
}

__global__ void __launch_bounds__(256) k_topk(P p) {
    const int tok = blockIdx.x, t = threadIdx.x;
    const __half* q = (const __half*)p.out + (size_t)tok * 2048;
    __shared__ float qs[256]; __shared__ float sc[256]; __shared__ float sv[2][16]; __shared__ int si[2][16];
    int* idx_out = (int*)(p.ws + OFF_IDX) + (size_t)tok * 128; float* gate_out = (float*)(p.ws + OFF_GATE) + (size_t)tok * 128;
    for (int h = 0; h < 8; ++h) {
        qs[t] = __half2float(q[h * 256 + t]);
        __syncthreads();
        {
            const int pp = t >> 7, k = t & 127;
            const float* key = p.peer_keys + ((size_t)((h * 2 + pp) * 128 + k)) * 128;
            float a = 0.f;
            for (int d = 0; d < 128; ++d) a += qs[pp * 128 + d] * key[d];
            sc[t] = a;
        }
        __syncthreads();
        if (t < 2) {
            float pv = INFINITY; int pi = -1;
            for (int r = 0; r < 16; ++r) {
                float bv = -INFINITY; int bi = -1;
                for (int k = 0; k < 128; ++k) {
                    const float v = sc[t * 128 + k];
                    const bool elig = (v < pv) || (v == pv && k > pi);
                    if (elig && (v > bv)) { bv = v; bi = k; }
                }
                sv[t][r] = bv; si[t][r] = bi; pv = bv; pi = bi;
            }
        }
        __syncthreads();
        if (t == 0) {
            float pv = INFINITY; int pi = -1; float fv[16]; int fi[16];
#pragma unroll
            for (int r = 0; r < 16; ++r) {
                float bv = -INFINITY; int bi = -1;
                for (int c = 0; c < 256; ++c) {
                    const float v = sv[0][c >> 4] + sv[1][c & 15];
                    const bool elig = (v < pv) || (v == pv && c > pi);
                    if (elig && (v > bv)) { bv = v; bi = c; }
                }
                fv[r] = bv; fi[r] = bi; pv = bv; pi = bi;
            }
            float mx = fv[0], sum = 0.f; float ex[16];
#pragma unroll
            for (int r = 0; r < 16; ++r) { ex[r] = expf(fv[r] - mx); sum += ex[r]; }
#pragma unroll
            for (int r = 0; r < 16; ++r) {
                const int c = fi[r];
                idx_out[h * 16 + r] = si[0][c >> 4] * 128 + si[1][c & 15];
                gate_out[h * 16 + r] = ex[r] / sum;
            }
        }
        __syncthreads();
    }
}

__global__ void __launch_bounds__(256) k_peer_out(P p) {
    const int tok = blockIdx.x * 4 + (threadIdx.x >> 6), lane = threadIdx.x & 63;
    const float* mod = (const float*)(p.ws + OFF_MOD) + cond_of_tok(tok) * 6144;
    const int* idx = (const int*)(p.ws + OFF_IDX) + (size_t)tok * 128; const float* gate = (const float*)(p.ws + OFF_GATE) + (size_t)tok * 128;
    float x1[16], h2[16], ff[16];
#pragma unroll
    for (int j = 0; j < 16; ++j) { const int k = j * 64 + lane; x1[j] = x1_of(p, tok, k); h2[j] = x1[j] * (1.f + mod[4096 + k]) + mod[3072 + k]; ff[j] = 0.f; }
    for (int pk = 0; pk < 128; ++pk) {
        const int e = idx[pk]; const float g = gate[pk];
        const float* ur = p.peer_u + (size_t)e * DM; const float* vr = p.peer_v + (size_t)e * DM;
        float a = 0.f;
#pragma unroll
        for (int j = 0; j < 16; ++j) a += h2[j] * ur[j * 64 + lane];
#pragma unroll
        for (int m = 1; m < 64; m <<= 1) a += __shfl_xor(a, m);
        const float w = g * geluf_(a);
#pragma unroll
        for (int j = 0; j < 16; ++j) ff[j] += w * vr[j * 64 + lane];
    }
    float y[16]; float s = 0.f;
#pragma unroll
    for (int j = 0; j < 16; ++j) { const int k = j * 64 + lane; y[j] = ALPHA_C * x1[j] + mod[5120 + k] * ff[j]; s += y[j]; }
#pragma unroll
    for (int m = 1; m < 64; m <<= 1) s += __shfl_xor(s, m);
    const float mu = s * (1.f / 1024.f); float q = 0.f;
#pragma unroll
    for (int j = 0; j < 16; ++j) { const float d = y[j] - mu; q += d * d; }
#pragma unroll
    for (int m = 1; m < 64; m <<= 1) q += __shfl_xor(q, m);
    const float rstd = rsqrtf(q * (1.f / 1024.f) + LN_EPS);
    float* o = p.out + (size_t)tok * DM;
#pragma unroll
    for (int j = 0; j < 16; ++j) { const int k = j * 64 + lane; o[k] = (y[j] - mu) * rstd * p.ln2_g[k] + p.ln2_b[k]; }
}

extern "C" void kernel_launch(void* const* d_in, const int* in_sizes, int n_in, void* d_out, int out_size, void* d_ws, size_t ws_size, hipStream_t stream) {
    P p{};
    const float** f = (const float**)&p;
    for (int i = 0; i < 27; ++i) f[i] = (const float*)d_in[i];
    p.out = (float*)d_out; p.ws = (char*)d_ws;
    k_mod<<<dim3(24, 9), 256, 0, stream>>>(p);
    k_sgemm<AF1, BF1, EPI1><<<dim3(DIN / 64, NTOK / 64), 256, 0, stream>>>(p, DM);
    k_hgrn<<<NSEQ * 8, 256, 0, stream>>>(p);
    k_rg<<<NSEQ * 16, 64, 0, stream>>>(p);
    k_combine<<<NTOK / 4, 256, 0, stream>>>(p);
    k_sgemm<AF3, BF3, EPI3><<<dim3(DM / 64, NTOK / 64), 256, 0, stream>>>(p, DM);
    k_ln1stats<<<NTOK / 4, 256, 0, stream>>>(p);
    k_sgemm<AF4, BF4, EPI4><<<dim3(2048 / 64, NTOK / 64), 256, 0, stream>>>(p, DM);
    k_topk<<<NTOK, 256, 0, stream>>>(p);
    k_peer_out<<<NTOK / 4, 256, 0, stream>>>(p);
}
```

```cpp
#include <hip/hip_runtime.h>
#include <hip/hip_bf16.h>
#include <hip/hip_fp16.h>
#include <cstdint>
#include <cstdio>

constexpr int DM = 1024;
constexpr int NTOK = 16384;
constexpr int NCTX_TOK = 8192;
constexpr int NSEQ = 40;
constexpr int DIN = 3584;
constexpr int HGW = 512, RGW = 512;
constexpr float ALPHA_C = 1.189207115002721f;
constexpr float LN_EPS = 1e-5f, RMS_EPS = 1e-6f;
constexpr size_t MB = 1u << 20;
constexpr size_t OFF_MOD = 0, OFF_LB = 256 << 10, OFF_STATS = 512 << 10, OFF_TT = 172 * MB  , OFF_BAR = 768 << 10, OFF_TSC = 896 << 10  , OFF_MODP = 16 * MB  ;
constexpr size_t OFF_SQ = 16 * MB, OFF_VV = 32 * MB, OFF_MIX = 16 * MB;
constexpr size_t OFF_SG = 48 * MB, OFF_GGR = 64 * MB, OFF_H2 = 48 * MB;
constexpr size_t OFF_WIN_T = 1 * MB, OFF_WOUT_T = 9 * MB, OFF_WQ_T = 11 * MB, OFF_KEYS16 = 15 * MB;
constexpr size_t OFF_LOGF = 80 * MB  , OFF_VBUF = 80 * MB;
constexpr size_t OFF_XR = 144 * MB, OFF_IDX = 144 * MB  , OFF_GATE = 152 * MB;
constexpr size_t OFF_HF = 176 * MB  , OFF_HIN = 176 * MB  , OFF_U8 = 240 * MB  , OFF_V8 = 160 * MB  ;
constexpr size_t OUT_STHG = 16777216, OUT_STRG = 20971520;

typedef unsigned short u16;
typedef float f32x4 __attribute__((ext_vector_type(4)));
__device__ __forceinline__ float bf2f(u16 v) { return __uint_as_float(((unsigned)v) << 16); }
__device__ __forceinline__ u16 f2bf(float f) { unsigned u = __float_as_uint(f); u += 0x7FFFu + ((u >> 16) & 1u); return (u16)(u >> 16); }
__device__ __forceinline__ float sigmoidf_(float x) { return 1.0f / (1.0f + expf(-x)); }
__device__ __forceinline__ float siluf_(float x) { return x / (1.0f + expf(-x)); }
__device__ __forceinline__ float geluf_(float x) { return 0.5f * x * (1.0f + tanhf(0.7978845608028654f * (x + 0.044715f * x * x * x))); }
__device__ __forceinline__ float fsigmoid(float x) { return __builtin_amdgcn_rcpf(1.0f + __expf(-x)); }
__device__ __forceinline__ float fsilu(float x) { return x * fsigmoid(x); }
__device__ __forceinline__ float fgelu(float x) { return x * fsigmoid(1.5957691216057308f * (x + 0.044715f * x * x * x)); }
__device__ __forceinline__ float softplusf_(float x) { return fmaxf(x, 0.f) + log1pf(expf(-fabsf(x))); }

__device__ __forceinline__ int seq_of_tok(int t) { return t < NCTX_TOK ? (t >> 8) : 32 + ((t - NCTX_TOK) >> 10); }
__device__ __forceinline__ int cond_of_tok(int t) { return t < NCTX_TOK ? 0 : 1 + ((t - NCTX_TOK) >> 10); }

__device__ __forceinline__ int tid_opaque() { int t = threadIdx.x; asm volatile("" : "+v"(t)); return t; }
struct P {
    const float *x_prompt, *x_sample, *c, *state_hgrn, *state_rglru, *c_ctx, *w_ada, *b_ada, *w_in, *hgrn_lb, *hgrn_norm_g, *conv_w, *conv_b,
        *rg_wr, *rg_br, *rg_wi, *rg_bi, *rg_lam, *w_out, *ln1_g, *ln1_b, *peer_wq, *peer_keys, *peer_u, *peer_v, *ln2_g, *ln2_b;
    float* out; char* ws;
};
__device__ __forceinline__ const float* xrow(const P& p, int t) { return t < NCTX_TOK ? p.x_prompt + (size_t)t * DM : p.x_sample + (size_t)(t - NCTX_TOK) * DM; }

#define XB_TMO      128
#define XB_XCNT(j)  (256  + 64 * (j))
#define XB_XSUB(j)  (1280 + 64 * (j))
#define XB_XGEN(j)  (2304 + 64 * (j))
#define XB_TOP      3328
#define XB_TOPGEN   3392
#define XCD_BAR_WORDS 3456
#define XB_SPIN_CAP (1u << 22)
#define LAS __attribute__((address_space(3)))
__device__ __forceinline__ unsigned xb_ld(unsigned* p) { return __hip_atomic_load(p, __ATOMIC_RELAXED, __HIP_MEMORY_SCOPE_AGENT); }
__device__ __forceinline__ unsigned xb_add(unsigned* p, unsigned v) { return __hip_atomic_fetch_add(p, v, __ATOMIC_RELAXED, __HIP_MEMORY_SCOPE_AGENT); }
__device__ __forceinline__ unsigned xb_xcc_id() { return (unsigned)__builtin_amdgcn_s_getreg((3 << 11) | 20) & 0xFu; }
#define XB_SPIN(cond, bar) do { unsigned _sp = 0; while (cond) { __builtin_amdgcn_s_sleep(1); \
    if ((++_sp & 255u) == 0u) { if (xb_ld(&(bar)[XB_TMO])) break; if (_sp > XB_SPIN_CAP) { atomicAdd(&(bar)[XB_TMO], 1u); break; } } } } while (0)
struct XcdBarrier { unsigned* bar; unsigned x; volatile LAS unsigned* st; };
__device__ __forceinline__ XcdBarrier xcd_barrier_post(unsigned* bar, volatile LAS unsigned* st) {
    XcdBarrier b; b.bar = bar; b.x = xb_xcc_id(); b.st = st;
    if (threadIdx.x == 0) (void)xb_add(&bar[XB_XCNT(b.x)], 1u);
    return b;
}
__device__ __forceinline__ void xcd_barrier_complete(unsigned* bar, unsigned x, unsigned& nloc, unsigned& nx) {
    const unsigned G = gridDim.x * gridDim.y * gridDim.z;
    unsigned sum, cnt, mine, sp = 0u;
    for (;;) {
        sum = 0u; cnt = 0u; mine = 0u;
#pragma unroll
        for (unsigned j = 0; j < 16; ++j) { const unsigned c = xb_ld(&bar[XB_XCNT(j)]); sum += c; cnt += (c > 0u) ? 1u : 0u; mine = (j == x) ? c : mine; }
        if (sum == G) break;
        __builtin_amdgcn_s_sleep(1);
        if ((++sp & 255u) == 0u) { if (xb_ld(&bar[XB_TMO])) break; if (sp > XB_SPIN_CAP) { atomicAdd(&bar[XB_TMO], 1u); break; } }
    }
    nloc = mine > 0u ? mine : 1u; nx = cnt > 0u ? cnt : 1u;
}
__device__ __forceinline__ void xcd_barrier(const XcdBarrier& b) {
    asm volatile("s_waitcnt vmcnt(0)" ::: "memory");
    __syncthreads();
    if (threadIdx.x == 0) {
        unsigned* bar = b.bar;
        __builtin_amdgcn_s_waitcnt(0);
        unsigned nloc = b.st[0], nx = b.st[1];
        if (nloc == 0u) { xcd_barrier_complete(bar, b.x, nloc, nx); b.st[0] = nloc; b.st[1] = nx; }
        const unsigned old = xb_add(&bar[XB_XSUB(b.x)], 1u);
        const unsigned gen = old / nloc;
        if (old + 1u == (gen + 1u) * nloc) {
            __builtin_amdgcn_fence(__ATOMIC_RELEASE, "agent");
            asm volatile("s_waitcnt vmcnt(0)" ::: "memory");
            const unsigned og = xb_add(&bar[XB_TOP], 1u);
            const unsigned tg = og / nx;
            if (og + 1u == (tg + 1u) * nx) xb_add(&bar[XB_TOPGEN], 1u);
            else XB_SPIN(xb_ld(&bar[XB_TOPGEN]) == tg, bar);
            __builtin_amdgcn_fence(__ATOMIC_ACQUIRE, "agent");
            xb_add(&bar[XB_XGEN(b.x)], 1u);
            asm volatile("s_waitcnt vmcnt(0)" ::: "memory");
        } else {
            XB_SPIN(xb_ld(&bar[XB_XGEN(b.x)]) == gen, bar);
            __builtin_amdgcn_fence(__ATOMIC_ACQUIRE, "agent");
            asm volatile("s_waitcnt vmcnt(0)" ::: "memory");
        }
    }
    __syncthreads();
}

template <int CTRL> __device__ __forceinline__ float dpp_f(float v) { return __builtin_bit_cast(float, __builtin_amdgcn_update_dpp(0, __builtin_bit_cast(int, v), CTRL, 0xF, 0xF, true)); }
__device__ __forceinline__ float sum16(float v) { v += dpp_f<0xB1>(v); v += dpp_f<0x4E>(v); v += dpp_f<0x141>(v); v += dpp_f<0x140>(v); return v; }
__device__ __forceinline__ float sum64(float v) { v = sum16(v); v += __shfl_xor(v, 16); v += __shfl_xor(v, 32); return v; }
__device__ __forceinline__ float max64(float v) {
    v = fmaxf(v, dpp_f<0xB1>(v)); v = fmaxf(v, dpp_f<0x4E>(v)); v = fmaxf(v, dpp_f<0x141>(v)); v = fmaxf(v, dpp_f<0x140>(v));
    v = fmaxf(v, __shfl_xor(v, 16)); v = fmaxf(v, __shfl_xor(v, 32)); return v;
}
typedef float f32x2 __attribute__((ext_vector_type(2)));
__device__ __forceinline__ void ph_mod1(const P& p, int item, char* smem) {
    const int cgp = item % 48, ks = item / 48;
    float* sc = (float*)smem;
    float* red = sc + 9 * 128;
    const int t = tid_opaque(), lane = t & 63, w = t >> 6;
    for (int i = t; i < 9 * 128; i += 256) { const int r = i >> 7, k = ks * 128 + (i & 127); sc[i] = siluf_(r == 0 ? p.c_ctx[k] : p.c[(size_t)(r - 1) * DM + k]); }
    const float* wp = p.w_ada + (size_t)(ks * 128 + w * 32) * 6144 + cgp * 128 + lane * 2;
    f32x2 wv[32];
#pragma unroll
    for (int k = 0; k < 32; ++k) wv[k] = *(const f32x2*)(wp + (size_t)k * 6144);
    __syncthreads();
    f32x2 acc[9];
#pragma unroll
    for (int r = 0; r < 9; ++r) acc[r] = (f32x2){0.f, 0.f};
#pragma unroll
    for (int k = 0; k < 32; ++k) {
#pragma unroll
        for (int r = 0; r < 9; ++r) acc[r] += wv[k] * sc[r * 128 + w * 32 + k];
    }
#pragma unroll
    for (int r = 0; r < 9; ++r) *(f32x2*)(red + (w * 9 + r) * 128 + lane * 2) = acc[r];
    __syncthreads();
    float* part = (float*)(p.ws + OFF_MODP) + (size_t)ks * 9 * 6144;
    for (int i = t; i < 9 * 128; i += 256) {
        const int r = i >> 7, c = i & 127;
        part[r * 6144 + cgp * 128 + c] = red[(0 * 9 + r) * 128 + c] + red[(1 * 9 + r) * 128 + c] + red[(2 * 9 + r) * 128 + c] + red[(3 * 9 + r) * 128 + c];
    }
    if (item == 0) {
        float* lb = (float*)(p.ws + OFF_LB);
        for (int i = t; i < 1024; i += 256) {
            int d = i >> 9, ch = i & 511;
            float l0 = p.hgrn_lb[(d * 2 + 0) * 512 + ch], l1 = p.hgrn_lb[(d * 2 + 1) * 512 + ch];
            float m = fmaxf(l0, l1); float e0 = expf(l0 - m), e1 = expf(l1 - m);
            lb[i] = e0 / (e0 + e1);
        }
    }
    __syncthreads();
}
__device__ __forceinline__ void ph_mod2(const P& p, int gtid, int gthreads) {
    float* mod = (float*)(p.ws + OFF_MOD); const float* part = (const float*)(p.ws + OFF_MODP);
    for (int i = gtid; i < 9 * 6144; i += gthreads) {
        float a = p.b_ada[i % 6144];
#pragma unroll
        for (int ks = 0; ks < 8; ++ks) a += part[(size_t)ks * 9 * 6144 + i];
        mod[i] = a;
    }
}

typedef __bf16 b16x8 __attribute__((ext_vector_type(8)));
typedef _Float16 h16x8 __attribute__((ext_vector_type(8)));
typedef float f32x16 __attribute__((ext_vector_type(16)));
typedef unsigned u32x4 __attribute__((ext_vector_type(4)));
typedef unsigned u32x2 __attribute__((ext_vector_type(2)));
__device__ __forceinline__ unsigned cvt_pk_bf16(float lo, float hi) { unsigned r; asm("v_cvt_pk_bf16_f32 %0, %1, %2" : "=v"(r) : "v"(lo), "v"(hi)); return r; }
__device__ __forceinline__ unsigned cvt_pk_f16(float lo, float hi) { typedef _Float16 h2 __attribute__((ext_vector_type(2))); h2 v; v.x = (_Float16)lo; v.y = (_Float16)hi; return __builtin_bit_cast(unsigned, v); }
template <bool F16> __device__ __forceinline__ f32x16 mfma32(u32x4 a, u32x4 b, f32x16 c) {
    if constexpr (F16) return __builtin_amdgcn_mfma_f32_32x32x16_f16(__builtin_bit_cast(h16x8, a), __builtin_bit_cast(h16x8, b), c, 0, 0, 0);
    else return __builtin_amdgcn_mfma_f32_32x32x16_bf16(__builtin_bit_cast(b16x8, a), __builtin_bit_cast(b16x8, b), c, 0, 0, 0);
}
template <bool F16> __device__ __forceinline__ f32x4 mfma16(u32x4 a, u32x4 b, f32x4 c) {
    if constexpr (F16) return __builtin_amdgcn_mfma_f32_16x16x32_f16(__builtin_bit_cast(h16x8, a), __builtin_bit_cast(h16x8, b), c, 0, 0, 0);
    else return __builtin_amdgcn_mfma_f32_16x16x32_bf16(__builtin_bit_cast(b16x8, a), __builtin_bit_cast(b16x8, b), c, 0, 0, 0);
}
__device__ __forceinline__ int lds_off(int row, int c) { return row * 128 + ((c ^ ((row >> 1) & 7)) << 4); }

template <bool F16, class EPI, int SHAPE = 0>
__device__ __forceinline__ void gemm_phase(const P& p, const u16* A16, int lda, const u16* Bt, int K, int NTN, int bid, int nb, char* smem) {
    EPI epi;
    const int t = tid_opaque(), lane = t & 63, wid = t >> 6, wm = wid >> 1, wn = wid & 1, r = lane & 31, h = lane >> 5;
    const int srow = t >> 3, kc = t & 7;
    const int ntiles = 16 * NTN, lstep = nb >> 3;
    int lt = bid >> 3;
    if (lt >= ntiles) return;
    u32x4 ra0[4], rb0[4], ra1[4], rb1[4];
    const u16* Ap; const u16* Bp;
    auto set_tile = [&](int l) {
        const int row0 = ((bid & 7) * 16 + l / NTN) * 128, col0 = (l % NTN) * 128;
        Ap = A16 + (size_t)(row0 + srow) * lda + kc * 8; Bp = Bt + (size_t)(col0 + srow) * K + kc * 8;
    };
    auto load_regs = [&](u32x4 (&ra)[4], u32x4 (&rb)[4], int k0) {
#pragma unroll
        for (int i = 0; i < 4; ++i) { ra[i] = *(const u32x4*)(Ap + (size_t)(32 * i) * lda + k0); rb[i] = *(const u32x4*)(Bp + (size_t)(32 * i) * K + k0); }
    };
    auto store_lds = [&](const u32x4 (&ra)[4], const u32x4 (&rb)[4], char* Ab, char* Bb) {
#pragma unroll
        for (int i = 0; i < 4; ++i) { *(u32x4*)(Ab + lds_off(srow + 32 * i, kc)) = ra[i]; *(u32x4*)(Bb + lds_off(srow + 32 * i, kc)) = rb[i]; }
    };
    char* A0 = smem; char* B0 = smem + 16384; char* A1 = smem + 32768; char* B1 = smem + 49152;
    const int nk = K / 64;
    set_tile(lt);
    load_regs(ra0, rb0, 0); load_regs(ra1, rb1, 64);
#pragma unroll 1
    for (; lt < ntiles; lt += lstep) {
        const int row0 = ((bid & 7) * 16 + lt / NTN) * 128, col0 = (lt % NTN) * 128;
        f32x16 acc[2][2]; f32x4 acc16[4][4];
        if constexpr (SHAPE == 0) {
#pragma unroll
        for (int i = 0; i < 2; ++i)
#pragma unroll
            for (int j = 0; j < 2; ++j)
#pragma unroll
                for (int e = 0; e < 16; ++e) acc[i][j][e] = 0.f;
        } else {
#pragma unroll
        for (int i = 0; i < 4; ++i)
#pragma unroll
            for (int j = 0; j < 4; ++j) acc16[i][j] = (f32x4){0.f, 0.f, 0.f, 0.f};
        }
        auto compute_store = [&](const char* Ab, const char* Bb, const u32x4 (&ra)[4], const u32x4 (&rb)[4], char* An, char* Bn) {
            if constexpr (SHAPE == 1) {
                const int l15 = lane & 15, l4 = lane >> 4;
#pragma unroll
                for (int ks = 0; ks < 2; ++ks) {
                    u32x4 af[4], bf[4];
#pragma unroll
                    for (int i = 0; i < 4; ++i) {
                        af[i] = *(const u32x4*)(Ab + lds_off(wm * 64 + i * 16 + l15, ks * 4 + l4));
                        bf[i] = *(const u32x4*)(Bb + lds_off(wn * 64 + i * 16 + l15, ks * 4 + l4));
                    }
#pragma unroll
                    for (int mh = 0; mh < 2; ++mh) {
#pragma unroll
                        for (int i = 2 * mh; i < 2 * mh + 2; ++i)
#pragma unroll
                            for (int j = 0; j < 4; ++j) acc16[i][j] = mfma16<F16>(af[i], bf[j], acc16[i][j]);
                        const int ci = ks * 2 + mh;
                        *(u32x4*)(An + lds_off(srow + 32 * ci, kc)) = ra[ci]; *(u32x4*)(Bn + lds_off(srow + 32 * ci, kc)) = rb[ci];
                        __builtin_amdgcn_sched_barrier(0);
                    }
                }
                return;
            }
#pragma unroll
            for (int ks = 0; ks < 4; ++ks) {
                u32x4 af[2], bf[2];
#pragma unroll
                for (int i = 0; i < 2; ++i) {
                    af[i] = *(const u32x4*)(Ab + lds_off(wm * 64 + i * 32 + r, ks * 2 + h));
                    bf[i] = *(const u32x4*)(Bb + lds_off(wn * 64 + i * 32 + r, ks * 2 + h));
                }
#pragma unroll
                for (int i = 0; i < 2; ++i)
#pragma unroll
                    for (int j = 0; j < 2; ++j) acc[i][j] = mfma32<F16>(af[i], bf[j], acc[i][j]);
                *(u32x4*)(An + lds_off(srow + 32 * ks, kc)) = ra[ks]; *(u32x4*)(Bn + lds_off(srow + 32 * ks, kc)) = rb[ks];
                __builtin_amdgcn_sched_barrier(0);
            }
        };
        store_lds(ra0, rb0, A0, B0);
        __syncthreads();
#pragma unroll 1
        for (int kt = 0; kt < nk; kt += 2) {
            load_regs(ra0, rb0, (kt + 2 < nk ? kt + 2 : nk - 1) * 64);
            compute_store(A0, B0, ra1, rb1, A1, B1);
            __syncthreads();
            load_regs(ra1, rb1, (kt + 3 < nk ? kt + 3 : nk - 1) * 64);
            compute_store(A1, B1, ra0, rb0, A0, B0);
            __syncthreads();
        }
        set_tile(lt + lstep < ntiles ? lt + lstep : lt);
        load_regs(ra0, rb0, 0); load_regs(ra1, rb1, 64);
        float* eb = (float*)(smem + wid * 16384);
        if constexpr (SHAPE == 0) {
#pragma unroll
        for (int i = 0; i < 2; ++i)
#pragma unroll
            for (int j = 0; j < 2; ++j)
#pragma unroll
                for (int e = 0; e < 16; ++e) eb[(i * 32 + (e & 3) + 8 * (e >> 2) + 4 * h) * 64 + j * 32 + r] = acc[i][j][e];
        } else {
#pragma unroll
        for (int i = 0; i < 4; ++i)
#pragma unroll
            for (int j = 0; j < 4; ++j)
#pragma unroll
                for (int e = 0; e < 4; ++e) eb[(i * 16 + (lane >> 4) * 4 + e) * 64 + j * 16 + (lane & 15)] = acc16[i][j][e];
        }
#pragma unroll
        for (int it = 0; it < 16; ++it) {
            const int rr = (lane >> 4) + 4 * it, cc = (lane & 15) * 4;
            const f32x4 v = *(const f32x4*)(eb + rr * 64 + cc);
            epi(p, row0 + wm * 64 + rr, col0 + wn * 64 + cc, v);
        }
        __syncthreads();
    }
}

__device__ __forceinline__ void ph_make_h(const P& p, int grp, char* smem) {
    float* ml = (float*)smem;
    const int t = tid_opaque();
    const int r = cond_of_tok(grp * 32);
    const float* part = (const float*)(p.ws + OFF_MODP) + (size_t)r * 6144;
#pragma unroll
    for (int i = 0; i < 8; ++i) {
        const int c = t + 256 * i;
        float a = p.b_ada[c];
#pragma unroll
        for (int ks = 0; ks < 8; ++ks) a += part[(size_t)ks * 9 * 6144 + c];
        ml[c] = a;
    }
    __syncthreads();
    u32x4* dst = (u32x4*)(p.ws + OFF_HIN);
#pragma unroll 4
    for (int i = 0; i < 16; ++i) {
        const int c = grp * 4096 + t + 256 * i;
        const int tok = c >> 7, k = (c & 127) * 8;
        const float* xr_ = xrow(p, tok) + k;
        const f32x4 a = *(const f32x4*)xr_, b = *(const f32x4*)(xr_ + 4);
        const f32x4 sh0 = *(const f32x4*)(ml + k), sh1 = *(const f32x4*)(ml + k + 4), sc0 = *(const f32x4*)(ml + 1024 + k), sc1 = *(const f32x4*)(ml + 1024 + k + 4);
        const f32x4 v0 = a * (sc0 + 1.0f) + sh0, v1 = b * (sc1 + 1.0f) + sh1;
        dst[c] = (u32x4){cvt_pk_bf16(v0[0], v0[1]), cvt_pk_bf16(v0[2], v0[3]), cvt_pk_bf16(v1[0], v1[1]), cvt_pk_bf16(v1[2], v1[3])};
    }
    __syncthreads();
}

__device__ __forceinline__ u32x2 pk4_bf16(f32x4 v) { return (u32x2){cvt_pk_bf16(v[0], v[1]), cvt_pk_bf16(v[2], v[3])}; }
struct EPI1 { __device__ __forceinline__ void operator()(const P& p, int t, int n, f32x4 z) const {
    const int part = n >> 9, c = n & 511; const size_t o = (size_t)t * 512 + c;
    const float* lb = (const float*)(p.ws + OFF_LB);
    if (part == 0) { f32x4 y; for (int j = 0; j < 4; ++j) y[j] = fsilu(z[j]); *(u32x2*)((u16*)(p.ws + OFF_SQ) + o) = pk4_bf16(y); }
    else if (part == 1) *(u32x2*)((u16*)(p.ws + OFF_VV) + o) = pk4_bf16(z);
    else if (part == 2 || part == 3) {
        const f32x4 l = *(const f32x4*)(lb + (part - 2) * 512 + c); f32x4 y;
        for (int j = 0; j < 4; ++j) y[j] = __logf(l[j] + (1.f - l[j]) * fsigmoid(z[j]));
        *(f32x4*)((float*)(p.ws + OFF_LOGF + (size_t)(part - 2) * 32 * MB) + o) = y;
    }
    else if (part == 4) { f32x4 y; for (int j = 0; j < 4; ++j) y[j] = fsilu(z[j]); *(u32x2*)((u16*)(p.ws + OFF_SG) + o) = pk4_bf16(y); }
    else if (part == 5) *(u32x2*)((u16*)(p.ws + OFF_XR) + o) = pk4_bf16(z);
    else { f32x4 y; for (int j = 0; j < 4; ++j) y[j] = fgelu(z[j]); *(u32x2*)((u16*)(p.ws + OFF_GGR) + o) = pk4_bf16(y); } } };
struct EPI3 { __device__ __forceinline__ void operator()(const P& p, int t, int n, f32x4 a) const {
    const float* mod = (const float*)(p.ws + OFF_MOD) + cond_of_tok(t) * 6144;
    const f32x4 x = *(const f32x4*)(xrow(p, t) + n), g1 = *(const f32x4*)(mod + 2048 + n);
    *(f32x4*)((float*)(p.ws + OFF_VBUF) + (size_t)t * DM + n) = x * ALPHA_C + g1 * a; } };
struct EPI4 { __device__ __forceinline__ void operator()(const P& p, int t, int n, f32x4 a) const {
    *(u32x2*)((u16*)p.out + (size_t)t * 2048 + n) = (u32x2){cvt_pk_f16(a[0], a[1]), cvt_pk_f16(a[2], a[3])}; } };
__device__ __forceinline__ float x1_of(const P& p, int t, int k) {
    const float* st = (const float*)(p.ws + OFF_STATS) + 2 * t;
    return (((const float*)(p.ws + OFF_VBUF))[(size_t)t * DM + k] - st[0]) * st[1] * p.ln1_g[k] + p.ln1_b[k];
}

template <bool F16>
__device__ __forceinline__ void ph_transpose(const float* src, u16* dst, int K, int N, int item, char* smem) {
    float (*tile)[65] = (float (*)[65])smem;
    const int ntn = N / 64, kt = item / ntn, nt = item % ntn, t = tid_opaque();
#pragma unroll
    for (int i = 0; i < 4; ++i) {
        const int k = (t >> 4) + 16 * i, n4 = (t & 15) * 4;
        const f32x4 v = *(const f32x4*)(src + (size_t)(kt * 64 + k) * N + nt * 64 + n4);
        tile[k][n4] = v[0]; tile[k][n4 + 1] = v[1]; tile[k][n4 + 2] = v[2]; tile[k][n4 + 3] = v[3];
    }
    __syncthreads();
    const int n = t >> 2, kq = (t & 3) * 16;
    unsigned w[8];
#pragma unroll
    for (int j = 0; j < 8; ++j) {
        const float a = tile[kq + 2 * j][n], b = tile[kq + 2 * j + 1][n];
        w[j] = F16 ? cvt_pk_f16(a, b) : cvt_pk_bf16(a, b);
    }
    u16* d = dst + (size_t)(nt * 64 + n) * K + kt * 64 + kq;
    *(u32x4*)d = (u32x4){w[0], w[1], w[2], w[3]}; *(u32x4*)(d + 8) = (u32x4){w[4], w[5], w[6], w[7]};
    __syncthreads();
}

__device__ __forceinline__ int hg_off(int row, int d) { return row * 256 + ((((d >> 3) ^ (row & 15)) << 4) | ((d & 7) << 1)); }
__device__ __forceinline__ void ph_hgrn(const P& p, int item, char* smem) {
    const int dh = item & 1, dir = (item >> 1) & 1, head = (item >> 2) & 3, seq = item >> 4;
    const int T = seq < 32 ? 256 : 1024;
    const int tok0 = seq < 32 ? seq * 256 : NCTX_TOK + (seq - 32) * 1024;
    const int t = tid_opaque(), lane = t & 63, w = t >> 6, r = lane & 31, hq = lane >> 5;
    const int pd = t & 63, ph = t >> 6;
    const int ve = t & 127, vh = t >> 7;
    char* qd = smem; char* kd = smem + 4096; char* keT = smem + 8192; char* vT = smem + 13312;
    float* decay = (float*)(smem + 23552); float* tot = (float*)(smem + 23808);
    char* rawq = smem + 24832; char* rawv = smem + 28928;
    const u16* sq = (const u16*)(p.ws + OFF_SQ);
    const u16* vv = (const u16*)(p.ws + OFF_VV);
    const float* lg = (const float*)(p.ws + OFF_LOGF + (size_t)dir * 32 * MB);
    u16* od = (u16*)p.out + (size_t)(dir * 2 + dh) * 8388608;
    const int chq = head * 128 + dh * 64;
    f32x16 S[2];
    if (seq >= 32) {
        const float* s0 = p.state_hgrn + ((size_t)((seq - 32) * 2 + dir) * 4 + head) * 16384;
#pragma unroll
        for (int db = 0; db < 2; ++db)
#pragma unroll
            for (int e = 0; e < 16; ++e) S[db][e] = s0[(size_t)(64 * dh + 32 * db + (e & 3) + 8 * (e >> 2) + 4 * hq) * 128 + 32 * w + r];
    } else {
#pragma unroll
        for (int db = 0; db < 2; ++db)
#pragma unroll
            for (int e = 0; e < 16; ++e) S[db][e] = 0.f;
    }
    const int nc = T / 32;
    const int phu = __builtin_amdgcn_readfirstlane(ph);
    const int wc = t >> 3, wg = t & 7;
    float plg[8]; u32x4 pq, pv0, pv1;
    auto prefetch = [&](int n) {
#pragma unroll
        for (int i = 0; i < 8; ++i) {
            const int sidx = n * 32 + phu * 8 + i;
            const int tok = tok0 + (dir ? T - 1 - sidx : sidx);
            plg[i] = (lg + (size_t)tok * 512 + chq)[pd];
        }
        const int sidx = n * 32 + wc;
        const size_t o = (size_t)(tok0 + (dir ? T - 1 - sidx : sidx)) * 512;
        pq = *(const u32x4*)(sq + o + chq + wg * 8);
        pv0 = *(const u32x4*)(vv + o + head * 128 + wg * 16); pv1 = *(const u32x4*)(vv + o + head * 128 + wg * 16 + 8);
    };
    prefetch(0);
    for (int n = 0; n < nc; ++n) {
        *(u32x4*)(rawq + wc * 128 + wg * 16) = pq;
        *(u32x4*)(rawv + wc * 256 + wg * 32) = pv0; *(u32x4*)(rawv + wc * 256 + wg * 32 + 16) = pv1;
        float cs[8], fk[8]; float run = 0.f;
#pragma unroll
        for (int i = 0; i < 8; ++i) { run += plg[i]; cs[i] = run; fk[i] = 1.f - __expf(plg[i]); }
        tot[ph * 64 + pd] = run;
        prefetch(n + 1 < nc ? n + 1 : n);
        __syncthreads();
        const float t0 = tot[pd], t1 = tot[64 + pd], t2 = tot[128 + pd], t3 = tot[192 + pd];
        const float off = ph == 0 ? 0.f : ph == 1 ? t0 : ph == 2 ? t0 + t1 : (t0 + t1) + t2;
        const float blast = (t0 + t1) + (t2 + t3);
        const float dcy = __expf(blast);
        if (ph == 0) decay[pd] = dcy;
        u16 qr[8], vr[16];
#pragma unroll
        for (int i = 0; i < 8; ++i) qr[i] = *(const u16*)(rawq + (ph * 8 + i) * 128 + pd * 2);
#pragma unroll
        for (int i = 0; i < 16; ++i) vr[i] = *(const u16*)(rawv + (vh * 16 + i) * 256 + ve * 2);
        __builtin_amdgcn_sched_barrier(0);
        unsigned ke[4];
#pragma unroll
        for (int i = 0; i < 8; i += 2) {
            float kev[2];
#pragma unroll
            for (int j = 0; j < 2; ++j) {
                const int c = ph * 8 + i + j;
                const float eb = __expf(off + cs[i + j]);
                const float kdv = fk[i + j] * __builtin_amdgcn_rcpf(eb);
                kev[j] = kdv * dcy;
                const int o2 = lds_off(c, pd >> 3) + (pd & 7) * 2;
                *(u16*)(qd + o2) = f2bf(bf2f(qr[i + j]) * eb);
                *(u16*)(kd + o2) = f2bf(kdv);
            }
            ke[i >> 1] = cvt_pk_bf16(kev[0], kev[1]);
        }
        *(u32x4*)(keT + pd * 80 + ph * 16) = (u32x4){ke[0], ke[1], ke[2], ke[3]};
        {
            unsigned vt[8];
#pragma unroll
            for (int i = 0; i < 8; ++i) vt[i] = (unsigned)vr[2 * i] | ((unsigned)vr[2 * i + 1] << 16);
            *(u32x4*)(vT + ve * 80 + vh * 32) = (u32x4){vt[0], vt[1], vt[2], vt[3]};
            *(u32x4*)(vT + ve * 80 + vh * 32 + 16) = (u32x4){vt[4], vt[5], vt[6], vt[7]};
        }
        __syncthreads();
        f32x16 att;
#pragma unroll
        for (int e = 0; e < 16; ++e) att[e] = 0.f;
        {
            u32x4 ka[4], qb[4];
#pragma unroll
            for (int ks = 0; ks < 4; ++ks) { const int o16 = lds_off(r, 2 * ks + hq); ka[ks] = *(const u32x4*)(kd + o16); qb[ks] = *(const u32x4*)(qd + o16); }
            __builtin_amdgcn_sched_barrier(0);
#pragma unroll
            for (int ks = 0; ks < 4; ++ks) att = mfma32<false>(ka[ks], qb[ks], att);
        }
#pragma unroll
        for (int e = 0; e < 16; ++e) { const int srow = (e & 3) + 8 * (e >> 2) + 4 * hq; att[e] = (srow <= r) ? att[e] : 0.f; }
        f32x16 o;
#pragma unroll
        for (int e = 0; e < 16; ++e) o[e] = 0.f;
#pragma unroll
        for (int sp = 0; sp < 2; ++sp) {
            const u32x4 pa = (u32x4){cvt_pk_bf16(att[8 * sp], att[8 * sp + 1]), cvt_pk_bf16(att[8 * sp + 2], att[8 * sp + 3]), cvt_pk_bf16(att[8 * sp + 4], att[8 * sp + 5]), cvt_pk_bf16(att[8 * sp + 6], att[8 * sp + 7])};
            const char* vrow = vT + (32 * w + r) * 80 + (16 * sp + 4 * hq) * 2;
            const u32x2 lo = *(const u32x2*)vrow, hi = *(const u32x2*)(vrow + 16);
            o = mfma32<false>(pa, (u32x4){lo.x, lo.y, hi.x, hi.y}, o);
        }
#pragma unroll
        for (int db = 0; db < 2; ++db)
#pragma unroll
            for (int sp = 0; sp < 2; ++sp) {
                const int d0 = 32 * db + 16 * sp + 4 * hq;
                const u32x2 lo = *(const u32x2*)(qd + lds_off(r, d0 >> 3) + (d0 & 7) * 2), hi = *(const u32x2*)(qd + lds_off(r, (d0 >> 3) + 1) + (d0 & 7) * 2);
                const u32x4 sb = (u32x4){cvt_pk_bf16(S[db][8 * sp], S[db][8 * sp + 1]), cvt_pk_bf16(S[db][8 * sp + 2], S[db][8 * sp + 3]), cvt_pk_bf16(S[db][8 * sp + 4], S[db][8 * sp + 5]), cvt_pk_bf16(S[db][8 * sp + 6], S[db][8 * sp + 7])};
                o = mfma32<false>((u32x4){lo.x, lo.y, hi.x, hi.y}, sb, o);
            }
#pragma unroll
        for (int db = 0; db < 2; ++db) {
#pragma unroll
            for (int g4 = 0; g4 < 4; ++g4) {
                const f32x4 dc = *(const f32x4*)(decay + 32 * db + 8 * g4 + 4 * hq);
#pragma unroll
                for (int j = 0; j < 4; ++j) S[db][4 * g4 + j] *= dc[j];
            }
#pragma unroll
            for (int ks = 0; ks < 2; ++ks) {
                const u32x4 a = *(const u32x4*)(keT + (32 * db + r) * 80 + ks * 32 + hq * 16);
                const u32x4 b = *(const u32x4*)(vT + (32 * w + r) * 80 + ks * 32 + hq * 16);
                S[db] = mfma32<false>(a, b, S[db]);
            }
        }
#pragma unroll
        for (int e = 0; e < 16; ++e) {
            const int c = (e & 3) + 8 * (e >> 2) + 4 * hq;
            const int sidx = n * 32 + c;
            const int tok = tok0 + (dir ? T - 1 - sidx : sidx);
            od[(size_t)tok * 512 + head * 128 + 32 * w + r] = f2bf(o[e]);
        }
    }
    if (seq < 32) {
        float* so = p.out + OUT_STHG + ((size_t)(seq * 2 + dir) * 4 + head) * 16384;
#pragma unroll
        for (int db = 0; db < 2; ++db)
#pragma unroll
            for (int e = 0; e < 16; ++e) so[(size_t)(64 * dh + 32 * db + (e & 3) + 8 * (e >> 2) + 4 * hq) * 128 + 32 * w + r] = S[db][e];
    }
}

__device__ __forceinline__ int rg_tok(int seq, int s) {
    if (seq < 32) return seq * 256 + s;
    const int col = s >> 4, row = s & 15;
    return NCTX_TOK + (seq - 32) * 1024 + row * 64 + col;
}
__device__ __forceinline__ void ph_rg_tiles(const P& p, int dirblk, int slot, int nslots, char* smem) {
    const int blk = dirblk & 7, dir = dirblk >> 3;
    const int t = tid_opaque(), lane = t & 63, w = t >> 6, r = lane & 31, hq = lane >> 5;
    const int ch = lane, sq = w, gch = blk * 64 + ch;
    char* WT = smem;
    char* XA = smem + 16384;
    float* G = (float*)(smem + 24576);
    float* car = (float*)(smem + 57344);
    const u16* xr = (const u16*)(p.ws + OFF_XR);
    u16* hlocp = (u16*)(p.ws + OFF_HF + (size_t)dir * 32 * MB); u16* acump = hlocp + (size_t)NTOK * 512;
    float* TT = (float*)(p.ws + OFF_TT);
    {
        const int n = t >> 1, kh = t & 1;
        const float* Wsrc = (n < 64 ? p.rg_wr : p.rg_wi) + ((size_t)(dir * 8 + blk) * 64) * 64 + (n & 63);
#pragma unroll
        for (int c4 = 0; c4 < 4; ++c4) {
            unsigned wv[4];
#pragma unroll
            for (int j = 0; j < 4; ++j) { const int k = kh * 32 + c4 * 8 + 2 * j; wv[j] = cvt_pk_bf16(Wsrc[(size_t)k * 64], Wsrc[(size_t)(k + 1) * 64]); }
            *(u32x4*)(WT + lds_off(n, kh * 4 + c4)) = (u32x4){wv[0], wv[1], wv[2], wv[3]};
        }
    }
    const float br = p.rg_br[dir * 512 + gch], bi = p.rg_bi[dir * 512 + gch];
    const float spl = softplusf_(-p.rg_lam[dir * 512 + gch]);
    const float cw0 = p.conv_w[0 * 512 + gch], cw1 = p.conv_w[1 * 512 + gch], cw2 = p.conv_w[2 * 512 + gch], cw3 = p.conv_w[3 * 512 + gch];
    const float cb = p.conv_b[gch];
    float win[19];
    auto load_win = [&](int ti_) {
        const int seq_ = ti_ < 128 ? (ti_ >> 2) : 32 + ((ti_ - 128) >> 4), j_ = ti_ < 128 ? (ti_ & 3) : ((ti_ - 128) & 15);
        const int T_ = seq_ < 32 ? 256 : 1024;
        const int s0_ = 64 * j_ + 16 * sq;
#pragma unroll
        for (int k = 0; k < 19; ++k) {
            const int pos = s0_ + k - 2;
            const bool ok = seq_ < 32 ? (pos >= 0 && pos < T_) : (k >= 2 && k < 18);
            const int posc = pos < 0 ? 0 : (pos >= T_ ? T_ - 1 : pos);
            const float v = bf2f(xr[(size_t)rg_tok(seq_, posc) * 512 + gch]);
            win[k] = ok ? v : 0.f;
        }
    };
    load_win(slot);
    for (int ti = slot; ti < 256; ti += nslots) {
        const int seq = ti < 128 ? (ti >> 2) : 32 + ((ti - 128) >> 4), j = ti < 128 ? (ti & 3) : ((ti - 128) & 15);
        const int s0 = 64 * j + 16 * sq;
        float xc[16];
#pragma unroll
        for (int i = 0; i < 16; ++i) {
            xc[i] = cb + cw0 * win[i] + cw1 * win[i + 1] + cw2 * win[i + 2] + cw3 * win[i + 3];
            *(u16*)(XA + lds_off(16 * sq + i, ch >> 3) + (ch & 7) * 2) = f2bf(xc[i]);
        }
        load_win(ti + nslots < 256 ? ti + nslots : ti);
        __syncthreads();
        {
            f32x16 acc[2];
#pragma unroll
            for (int mt = 0; mt < 2; ++mt)
#pragma unroll
                for (int e = 0; e < 16; ++e) acc[mt][e] = 0.f;
#pragma unroll
            for (int ks = 0; ks < 4; ++ks) {
                const u32x4 b = *(const u32x4*)(WT + lds_off(32 * w + r, 2 * ks + hq));
#pragma unroll
                for (int mt = 0; mt < 2; ++mt) {
                    const u32x4 a = *(const u32x4*)(XA + lds_off(32 * mt + r, 2 * ks + hq));
                    acc[mt] = mfma32<false>(a, b, acc[mt]);
                }
            }
#pragma unroll
            for (int mt = 0; mt < 2; ++mt)
#pragma unroll
                for (int e = 0; e < 16; ++e) G[(32 * mt + (e & 3) + 8 * (e >> 2) + 4 * hq) * 128 + 32 * w + r] = acc[mt][e];
        }
        __syncthreads();
        float av[16], uv[16];
#pragma unroll
        for (int i = 0; i < 16; ++i) {
            const float gr_ = G[(16 * sq + i) * 128 + ch] + br, gi_ = G[(16 * sq + i) * 128 + 64 + ch] + bi;
            const float rr = fsigmoid(gr_), ig = fsigmoid(gi_);
            const float log_a = -8.0f * rr * spl;
            const float a_ = __expf(log_a);
            av[i] = a_;
            uv[i] = __builtin_amdgcn_sqrtf(fmaxf(1.0f - a_ * a_, 0.f)) * (ig * xc[i]);
        }
        float Ap = 1.f, Hl = 0.f;
#pragma unroll
        for (int ii = 0; ii < 16; ++ii) { const int i = dir ? 15 - ii : ii; Hl = av[i] * Hl + uv[i]; Ap *= av[i]; }
        car[sq * 64 + ch] = Ap; car[256 + sq * 64 + ch] = Hl;
        __syncthreads();
        float h = 0.f, ac = 1.f;
#pragma unroll
        for (int qq = 0; qq < 3; ++qq) {
            const int qo = dir ? 3 - qq : qq;
            const bool before = dir ? (qo > sq) : (qo < sq);
            const float cA = car[qo * 64 + ch], cH = car[256 + qo * 64 + ch];
            h = before ? cA * h + cH : h; ac = before ? ac * cA : ac;
        }
#pragma unroll
        for (int ii = 0; ii < 16; ++ii) {
            const int i = dir ? 15 - ii : ii;
            h = av[i] * h + uv[i]; ac *= av[i];
            const size_t o = (size_t)rg_tok(seq, s0 + i) * 512 + gch;
            hlocp[o] = f2bf(h); acump[o] = f2bf(ac);
        }
        if (sq == (dir ? 0 : 3)) { TT[((size_t)(ti * 2 + dir) * 2 + 0) * 512 + gch] = ac; TT[((size_t)(ti * 2 + dir) * 2 + 1) * 512 + gch] = h; }
    }
    __syncthreads();
}

__device__ __forceinline__ void ph_combine(const P& p, int item, char* smem) {
    const int tq = tid_opaque(); const int lane = tq & 63, wv = tq >> 6;
    const int ti = item >> 1, half = item & 1;
    const int seq = ti < 128 ? (ti >> 2) : 32 + ((ti - 128) >> 4), j = ti < 128 ? (ti & 3) : ((ti - 128) & 15);
    const int nt = seq < 32 ? 4 : 16, tib = ti - j;
    float* carF = (float*)smem; float* carB = carF + 512;
    const float* TT = (const float*)(p.ws + OFF_TT);
#pragma unroll
    for (int cc = 0; cc < 2; ++cc) {
        const int ch = tq + 256 * cc;
        float hf = seq >= 32 ? p.state_rglru[(size_t)((seq - 32) * 2 + 0) * 512 + ch] : 0.f;
        float hb = seq >= 32 ? p.state_rglru[(size_t)((seq - 32) * 2 + 1) * 512 + ch] : 0.f;
        for (int jj = 0; jj < j; ++jj) { const float* q = TT + ((size_t)((tib + jj) * 2 + 0) * 2) * 512 + ch; hf = q[0] * hf + q[512]; }
        for (int jj = nt - 1; jj > j; --jj) { const float* q = TT + ((size_t)((tib + jj) * 2 + 1) * 2) * 512 + ch; hb = q[0] * hb + q[512]; }
        carF[ch] = hf; carB[ch] = hb;
        if (seq < 32 && half == 0) {
            if (j == nt - 1) { const float* q = TT + ((size_t)(ti * 2 + 0) * 2) * 512 + ch; p.out[OUT_STRG + (size_t)(seq * 2 + 0) * 512 + ch] = q[0] * hf + q[512]; }
            if (j == 0)      { const float* q = TT + ((size_t)(ti * 2 + 1) * 2) * 512 + ch; p.out[OUT_STRG + (size_t)(seq * 2 + 1) * 512 + ch] = q[0] * hb + q[512]; }
        }
    }
    __syncthreads();
    const f32x4 ng0 = *(const f32x4*)(p.hgrn_norm_g + lane * 8), ng1 = *(const f32x4*)(p.hgrn_norm_g + lane * 8 + 4);
    const f32x4 cf0 = *(const f32x4*)(carF + lane * 8), cf1 = *(const f32x4*)(carF + lane * 8 + 4), cb0 = *(const f32x4*)(carB + lane * 8), cb1 = *(const f32x4*)(carB + lane * 8 + 4);
    const u16* HL = (const u16*)(p.ws + OFF_HF);
#pragma unroll 1
    for (int it = 0; it < 4; ++it) {
        u32x4 oA[2], oB[2], oC[2], oD[2]; u32x4 sgv[2], grv[2], lf[2], af[2], lb[2], ab[2]; int tokv[2];
#pragma unroll
        for (int u = 0; u < 2; ++u) {
            const int i = wv * 8 + it * 2 + u;
            const int s = 64 * j + 32 * half + i;
            const int tok = rg_tok(seq, s); tokv[u] = tok;
            const size_t o = (size_t)tok * 512 + lane * 8;
            const u16* op = (const u16*)p.out + o;
            oA[u] = *(const u32x4*)op; oB[u] = *(const u32x4*)(op + 8388608); oC[u] = *(const u32x4*)(op + 2 * 8388608); oD[u] = *(const u32x4*)(op + 3 * 8388608);
            lf[u] = *(const u32x4*)(HL + o); af[u] = *(const u32x4*)(HL + (size_t)NTOK * 512 + o);
            lb[u] = *(const u32x4*)(HL + (size_t)32 * MB / 2 + o); ab[u] = *(const u32x4*)(HL + (size_t)32 * MB / 2 + (size_t)NTOK * 512 + o);
            sgv[u] = *(const u32x4*)((const u16*)(p.ws + OFF_SG) + o); grv[u] = *(const u32x4*)((const u16*)(p.ws + OFF_GGR) + o);
        }
#pragma unroll
        for (int u = 0; u < 2; ++u) {
            f32x4 o0, o1;
#pragma unroll
            for (int jq = 0; jq < 4; ++jq) {
                const float lo = (__uint_as_float(oA[u][jq] << 16) + __uint_as_float(oB[u][jq] << 16)) + (__uint_as_float(oC[u][jq] << 16) + __uint_as_float(oD[u][jq] << 16));
                const float hi = (__uint_as_float(oA[u][jq] & 0xFFFF0000u) + __uint_as_float(oB[u][jq] & 0xFFFF0000u)) + (__uint_as_float(oC[u][jq] & 0xFFFF0000u) + __uint_as_float(oD[u][jq] & 0xFFFF0000u));
                if (jq < 2) { o0[2 * jq] = lo; o0[2 * jq + 1] = hi; } else { o1[2 * jq - 4] = lo; o1[2 * jq - 3] = hi; }
            }
            float ss = (o0[0] * o0[0] + o0[1] * o0[1]) + (o0[2] * o0[2] + o0[3] * o0[3]) + (o1[0] * o1[0] + o1[1] * o1[1]) + (o1[2] * o1[2] + o1[3] * o1[3]);
            ss = sum16(ss);
            const float rs = rsqrtf(ss * (1.f / 128.f) + RMS_EPS);
            unsigned mw[4], yw[4];
#pragma unroll
            for (int jq = 0; jq < 4; ++jq) {
                const float m0 = (jq < 2 ? o0[2 * jq] : o1[2 * jq - 4]) * rs * (jq < 2 ? ng0[2 * jq] : ng1[2 * jq - 4]);
                const float m1 = (jq < 2 ? o0[2 * jq + 1] : o1[2 * jq - 3]) * rs * (jq < 2 ? ng0[2 * jq + 1] : ng1[2 * jq - 3]);
                const float cfa = jq < 2 ? cf0[2 * jq] : cf1[2 * jq - 4], cfb = jq < 2 ? cf0[2 * jq + 1] : cf1[2 * jq - 3];
                const float cba = jq < 2 ? cb0[2 * jq] : cb1[2 * jq - 4], cbb = jq < 2 ? cb0[2 * jq + 1] : cb1[2 * jq - 3];
                const unsigned l1 = lf[u][jq], c1 = af[u][jq], l2 = lb[u][jq], c2 = ab[u][jq];
                const float y0 = (__uint_as_float(l1 << 16) + __uint_as_float(c1 << 16) * cfa) + (__uint_as_float(l2 << 16) + __uint_as_float(c2 << 16) * cba);
                const float y1 = (__uint_as_float(l1 & 0xFFFF0000u) + __uint_as_float(c1 & 0xFFFF0000u) * cfb) + (__uint_as_float(l2 & 0xFFFF0000u) + __uint_as_float(c2 & 0xFFFF0000u) * cbb);
                const unsigned sgp = sgv[u][jq], grp = grv[u][jq];
                mw[jq] = cvt_pk_bf16(m0 * __uint_as_float(sgp << 16), m1 * __uint_as_float(sgp & 0xFFFF0000u));
                yw[jq] = cvt_pk_bf16(y0 * __uint_as_float(grp << 16), y1 * __uint_as_float(grp & 0xFFFF0000u));
            }
            u16* mix = (u16*)(p.ws + OFF_MIX) + (size_t)tokv[u] * DM + lane * 8;
            *(u32x4*)mix = (u32x4){mw[0], mw[1], mw[2], mw[3]};
            *(u32x4*)(mix + 512) = (u32x4){yw[0], yw[1], yw[2], yw[3]};
        }
    }
    __syncthreads();
}

__device__ __forceinline__ void ph_ln1stats(const P& p, int item) {
    const int tq = tid_opaque(); const int lane = tq & 63;
    const int tokb = item * 16 + (tq >> 6) * 4;
    f32x4 x[4][4];
#pragma unroll
    for (int u = 0; u < 4; ++u) {
        const float* v = (const float*)(p.ws + OFF_VBUF) + (size_t)(tokb + u) * DM + lane * 16;
#pragma unroll
        for (int c = 0; c < 4; ++c) x[u][c] = *(const f32x4*)(v + c * 4);
    }
    f32x4 lg[4], lbb[4];
#pragma unroll
    for (int c = 0; c < 4; ++c) { lg[c] = *(const f32x4*)(p.ln1_g + lane * 16 + c * 4); lbb[c] = *(const f32x4*)(p.ln1_b + lane * 16 + c * 4); }
#pragma unroll
    for (int u = 0; u < 4; ++u) {
        const int tok = tokb + u;
        float s = 0.f;
#pragma unroll
        for (int c = 0; c < 4; ++c) s += (x[u][c][0] + x[u][c][1]) + (x[u][c][2] + x[u][c][3]);
        s = sum64(s);
        const float mu = s * (1.f / 1024.f); float q = 0.f;
#pragma unroll
        for (int c = 0; c < 4; ++c)
#pragma unroll
            for (int j = 0; j < 4; ++j) { const float d = x[u][c][j] - mu; q += d * d; }
        q = sum64(q);
        const float rstd = rsqrtf(q * (1.f / 1024.f) + LN_EPS);
        if (lane == 0) { float* st = (float*)(p.ws + OFF_STATS) + 2 * tok; st[0] = mu; st[1] = rstd; }
        const float* mod = (const float*)(p.ws + OFF_MOD) + cond_of_tok(tok) * 6144;
        unsigned hw[8];
#pragma unroll
        for (int c = 0; c < 4; ++c) {
            const int k = lane * 16 + c * 4;
            const f32x4 sc2 = *(const f32x4*)(mod + 4096 + k), sh2 = *(const f32x4*)(mod + 3072 + k);
            float h[4];
#pragma unroll
            for (int j = 0; j < 4; ++j) { const float x1 = (x[u][c][j] - mu) * rstd * lg[c][j] + lbb[c][j]; h[j] = x1 * (1.f + sc2[j]) + sh2[j]; }
            hw[2 * c] = cvt_pk_f16(h[0], h[1]); hw[2 * c + 1] = cvt_pk_f16(h[2], h[3]);
        }
        u16* h2 = (u16*)(p.ws + OFF_H2) + (size_t)tok * DM + lane * 16;
        *(u32x4*)h2 = (u32x4){hw[0], hw[1], hw[2], hw[3]}; *(u32x4*)(h2 + 8) = (u32x4){hw[4], hw[5], hw[6], hw[7]};
    }
}

__device__ __forceinline__ unsigned f2sort(float f) { const unsigned u = __float_as_uint(f); return (u & 0x80000000u) ? ~u : (u | 0x80000000u); }
__device__ __forceinline__ float sort2f(unsigned k) { const unsigned u = (k & 0x80000000u) ? (k & 0x7FFFFFFFu) : ~k; return __uint_as_float(u); }
template <int N> __device__ __forceinline__ void bitonic_sort_desc(unsigned (&v)[N]) {
#pragma unroll
    for (int k = 2; k <= N; k <<= 1)
#pragma unroll
        for (int j = k >> 1; j > 0; j >>= 1)
#pragma unroll
            for (int i = 0; i < N; ++i) {
                const int l = i ^ j;
                if (l > i) {
                    const bool desc = ((i & k) == 0);
                    const unsigned a = v[i], b = v[l];
                    const unsigned mx = a > b ? a : b, mn = a > b ? b : a;
                    v[i] = desc ? mx : mn; v[l] = desc ? mn : mx;
                }
            }
}
__device__ __forceinline__ void merge_top16(unsigned (&a)[16], const unsigned (&b)[16]) {
#pragma unroll
    for (int i = 0; i < 16; ++i) a[i] = a[i] > b[15 - i] ? a[i] : b[15 - i];
#pragma unroll
    for (int j = 8; j > 0; j >>= 1)
#pragma unroll
        for (int i = 0; i < 16; ++i) {
            const int l = i ^ j;
            if (l > i) { const unsigned x = a[i], y = a[l]; a[i] = x > y ? x : y; a[l] = x > y ? y : x; }
        }
}
struct CandTab { unsigned char v[64]; };
__host__ __device__ constexpr CandTab make_ctab() {
    CandTab t{}; int n = 0;
    for (int f = 0; f < 256; ++f) { const int i = f >> 4, j = f & 15; if ((i + 1) * (j + 1) <= 16) t.v[n++] = (unsigned char)f; }
    for (; n < 64; ++n) t.v[n] = 255;
    return t;
}
__device__ const CandTab g_ctab = make_ctab();

__device__ __forceinline__ void ph_topk_load_keys(const P& p, int head, char* smem) {
    const int t = tid_opaque();
    const u16* ksrc = (const u16*)(p.ws + OFF_KEYS16) + (size_t)head * 2 * 128 * 128;
#pragma unroll
    for (int i = 0; i < 16; ++i) {
        const int cidx = t + 256 * i, row = cidx >> 4, ch = cidx & 15;
        *(u32x4*)(smem + row * 256 + ((ch ^ (row & 15)) << 4)) = *(const u32x4*)(ksrc + row * 128 + ch * 8);
    }
}
__device__ __forceinline__ void ph_topk(const P& p, int item, int next_item, u32x4 (&qf)[8], char* smem) {
    const int tile = item >> 3, head = item & 7;
    const int t = tid_opaque(), lane = t & 63, wid = t >> 6, tt = wid & 1, pp = wid >> 1, r = lane & 31, hq = lane >> 5;
    unsigned* topk = (unsigned*)(smem + 65536);
    unsigned char* ctab = (unsigned char*)(smem + 65536 + 8192);
    if (t < 64) ctab[t] = g_ctab.v[t];
    const int tok0 = tile * 64;
    {
        unsigned srt[4][16];
#pragma unroll
        for (int kb = 0; kb < 4; ++kb) {
            u32x4 kf[8];
#pragma unroll
            for (int ks = 0; ks < 8; ++ks) kf[ks] = *(const u32x4*)(smem + (pp * 128 + kb * 32 + r) * 256 + (((2 * ks + hq) ^ (r & 15)) << 4));
            f32x16 acc;
#pragma unroll
            for (int e = 0; e < 16; ++e) acc[e] = 0.f;
#pragma unroll
            for (int ks = 0; ks < 8; ++ks) acc = mfma32<true>(kf[ks], qf[ks], acc);
#pragma unroll
            for (int e = 0; e < 16; ++e) {
                const int kidx = kb * 32 + (e & 3) + 8 * (e >> 2);
                srt[kb][e] = (f2sort(acc[e]) & ~127u) | (unsigned)(127 - kidx - 4 * hq);
            }
            bitonic_sort_desc<16>(srt[kb]);
        }
        {
            const u16* qrow = (const u16*)p.out + (size_t)((next_item >> 3) * 64 + tt * 32 + r) * 2048 + head * 256 + pp * 128 + hq * 8;
#pragma unroll
            for (int ks = 0; ks < 8; ++ks) qf[ks] = *(const u32x4*)(qrow + ks * 16);
        }
        merge_top16(srt[0], srt[1]); merge_top16(srt[2], srt[3]); merge_top16(srt[0], srt[2]);
        unsigned oth[16];
#pragma unroll
        for (int i = 0; i < 16; ++i) oth[i] = (unsigned)__shfl_xor((int)srt[0][i], 32);
        merge_top16(srt[0], oth);
        if (hq == 0) {
            u32x4* d = (u32x4*)(topk + ((tt * 32 + r) * 2 + pp) * 16);
#pragma unroll
            for (int i = 0; i < 4; ++i) d[i] = (u32x4){srt[0][4 * i], srt[0][4 * i + 1], srt[0][4 * i + 2], srt[0][4 * i + 3]};
        }
    }
    __syncthreads();
    {
        const int m = wid * 16 + (lane >> 2), sub = lane & 3;
        const unsigned* tk0 = topk + (m * 2 + 0) * 16; const unsigned* tk1 = tk0 + 16;
        unsigned cd[16];
#pragma unroll
        for (int n = 0; n < 16; ++n) {
            const int pos = sub * 16 + n;
            const unsigned f = ctab[pos];
            const unsigned k0 = tk0[(f >> 4) & 15], k1 = tk1[f & 15];
            const float cv = sort2f(k0 & ~127u) + sort2f(k1 & ~127u);
            cd[n] = (f == 255u) ? 0u : ((f2sort(cv) & ~63u) | (unsigned)(63 - pos));
        }
        bitonic_sort_desc<16>(cd);
        unsigned oth[16];
#pragma unroll
        for (int i = 0; i < 16; ++i) oth[i] = (unsigned)__shfl_xor((int)cd[i], 1);
        merge_top16(cd, oth);
#pragma unroll
        for (int i = 0; i < 16; ++i) oth[i] = (unsigned)__shfl_xor((int)cd[i], 2);
        merge_top16(cd, oth);
        float ex[16]; float sum = 0.f;
        const float f0 = sort2f(cd[0] & ~63u);
#pragma unroll
        for (int i = 0; i < 16; ++i) { ex[i] = __expf(sort2f(cd[i] & ~63u) - f0); sum += ex[i]; }
        const float inv = 1.0f / sum;
        int* idx_out = (int*)(p.ws + OFF_IDX) + (size_t)(tok0 + m) * 128 + head * 16 + sub * 4;
        float* gate_out = (float*)(p.ws + OFF_GATE) + (size_t)(tok0 + m) * 128 + head * 16 + sub * 4;
        int eo[4]; float go[4];
#pragma unroll
        for (int i = 0; i < 4; ++i) {
            const unsigned kk = sub == 0 ? cd[i] : sub == 1 ? cd[4 + i] : sub == 2 ? cd[8 + i] : cd[12 + i];
            const float ee = sub == 0 ? ex[i] : sub == 1 ? ex[4 + i] : sub == 2 ? ex[8 + i] : ex[12 + i];
            const unsigned f = ctab[63 - (kk & 63u)];
            const unsigned k0 = tk0[(f >> 4) & 15], k1 = tk1[f & 15];
            eo[i] = (int)((127u - (k0 & 127u)) * 128u + (127u - (k1 & 127u)));
            go[i] = ee * inv;
        }
        *(int4*)idx_out = make_int4(eo[0], eo[1], eo[2], eo[3]);
        *(f32x4*)gate_out = (f32x4){go[0], go[1], go[2], go[3]};
    }
    __syncthreads();
}

typedef unsigned v6u32 __attribute__((ext_vector_type(6)));
typedef _Float16 v32h __attribute__((ext_vector_type(32)));
typedef float v32f __attribute__((ext_vector_type(32)));
__device__ __forceinline__ void ph_cvt_tables(const P& p, int gwave, int nwaves, char* smem, int row_lo = 0, int row_hi = 2 * 16384) {
    const int tq = tid_opaque(), lane = tq & 63, rsub = lane >> 5, gi = lane & 31, q = gi >> 1, half = gi & 1;
    float* SC = (float*)(p.ws + OFF_TSC);
    float* tl = (float*)(smem + (tq >> 6) * 18432);
    for (int row0 = row_lo + gwave * 4; row0 < row_hi; row0 += nwaves * 4) {
        f32x4 x[4][4];
#pragma unroll
        for (int rr = 0; rr < 4; ++rr) {
            const int row = row0 + rr;
            const float* src = (row < 16384 ? p.peer_u + (size_t)row * DM : p.peer_v + (size_t)(row - 16384) * DM) + lane * 4;
#pragma unroll
            for (int i = 0; i < 4; ++i) x[rr][i] = __builtin_nontemporal_load((const f32x4*)(src + i * 256));
        }
#pragma unroll
        for (int rr = 0; rr < 4; ++rr)
#pragma unroll
            for (int i = 0; i < 4; ++i) *(f32x4*)(tl + rr * 1152 + (8 * i + (lane >> 3)) * 36 + 4 * (lane & 7)) = x[rr][i];
#pragma unroll
        for (int pr = 0; pr < 2; ++pr) {
            const int row = row0 + pr * 2 + rsub;
            f32x4 y[8];
#pragma unroll
            for (int i = 0; i < 8; ++i) y[i] = *(const f32x4*)(tl + (pr * 2 + rsub) * 1152 + gi * 36 + i * 4);
            float am = 0.f;
#pragma unroll
            for (int i = 0; i < 8; ++i) am = fmaxf(am, fmaxf(fmaxf(fabsf(y[i][0]), fabsf(y[i][1])), fmaxf(fabsf(y[i][2]), fabsf(y[i][3]))));
            am = fmaxf(am, dpp_f<0xB1>(am)); am = fmaxf(am, dpp_f<0x4E>(am)); am = fmaxf(am, dpp_f<0x141>(am)); am = fmaxf(am, dpp_f<0x140>(am));
            am = fmaxf(am, __shfl_xor(am, 16));
            const float inv = am > 0.f ? 7.5f / am : 1.0f;
            v32h xh;
#pragma unroll
            for (int i = 0; i < 8; ++i)
#pragma unroll
                for (int j = 0; j < 4; ++j) xh[i * 4 + j] = (_Float16)(y[i][j] * inv);
            const v6u32 pk = __builtin_amdgcn_cvt_scalef32_pk32_fp6_f16(xh, 1.0f);
            char* dst = (row < 16384 ? p.ws + OFF_U8 + (size_t)row * 768 : p.ws + OFF_V8 + (size_t)(row - 16384) * 768) + q * 16;
            if (half == 0) { *(u32x4*)dst = (u32x4){pk[0], pk[1], pk[2], pk[3]}; *(u32x2*)(dst + 256) = (u32x2){pk[4], pk[5]}; }
            else { *(u32x2*)(dst + 256 + 8) = (u32x2){pk[0], pk[1]}; *(u32x4*)(dst + 512) = (u32x4){pk[2], pk[3], pk[4], pk[5]}; }
            if (gi == 0) SC[row] = am > 0.f ? am * (1.0f / 7.5f) : 1.0f;
        }
    }
}

typedef _Float16 h16x2 __attribute__((ext_vector_type(2)));
__device__ __forceinline__ h16x2 ash2(unsigned u) { return __builtin_bit_cast(h16x2, u); }

__device__ __forceinline__ void sort128_group(unsigned (&key)[8], int q) {
#pragma unroll
    for (int k = 2; k <= 128; k <<= 1)
#pragma unroll
        for (int j = k >> 1; j > 0; j >>= 1) {
            if (j < 8) {
#pragma unroll
                for (int r = 0; r < 8; ++r) {
                    const int r2 = r ^ j;
                    if (r2 > r) {
                        const bool asc = (((q << 3) | r) & k) == 0;
                        const unsigned a = key[r], b = key[r2];
                        const unsigned lo = a < b ? a : b, hi = a < b ? b : a;
                        key[r] = asc ? lo : hi; key[r2] = asc ? hi : lo;
                    }
                }
            } else {
                const int m = j >> 3;
                const bool lower = (q & m) == 0, asc = ((q << 3) & k) == 0;
                const bool takemin = lower == asc;
#pragma unroll
                for (int r = 0; r < 8; ++r) {
                    const unsigned o = (unsigned)__shfl_xor((int)key[r], m);
                    const unsigned a = key[r];
                    key[r] = takemin ? (a < o ? a : o) : (a < o ? o : a);
                }
            }
        }
}
__device__ __forceinline__ void ph_peer_out(const P& p, int item, char* smem) {
    const int tq = tid_opaque(); const int lane = tq & 63, g = lane >> 4, q = lane & 15;
    const int tok = item * 16 + (tq >> 6) * 4 + g;
    const unsigned char* U8 = (const unsigned char*)(p.ws + OFF_U8); const unsigned char* V8 = (const unsigned char*)(p.ws + OFF_V8);
    const float* SU = (const float*)(p.ws + OFF_TSC); const float* SV = SU + 16384;
    const u16* H2 = (const u16*)(p.ws + OFF_H2) + (size_t)tok * DM;
    u32x4 hh[8];
#pragma unroll
    for (int i = 0; i < 8; ++i) hh[i] = *(const u32x4*)(H2 + q * 64 + i * 8);
    unsigned key[8];
    {
        const int* idx = (const int*)(p.ws + OFF_IDX) + (size_t)tok * 128 + q * 8; const float* gate = (const float*)(p.ws + OFF_GATE) + (size_t)tok * 128 + q * 8;
        const int4 ia = *(const int4*)idx, ib = *(const int4*)(idx + 4);
        const f32x4 ga = *(const f32x4*)gate, gb = *(const f32x4*)(gate + 4);
        const int iv[8] = {ia.x, ia.y, ia.z, ia.w, ib.x, ib.y, ib.z, ib.w};
        const float gv[8] = {ga[0], ga[1], ga[2], ga[3], gb[0], gb[1], gb[2], gb[3]};
#pragma unroll
        for (int r = 0; r < 8; ++r) { unsigned gq = (unsigned)(gv[r] * 262144.0f + 0.5f); gq = gq > 262143u ? 262143u : gq; key[r] = ((unsigned)iv[r] << 18) | gq; }
    }
    sort128_group(key, q);
    unsigned* kl = (unsigned*)(smem + (tq >> 6) * 16384) + g * 128;
    *(u32x4*)(kl + q * 8) = (u32x4){key[0], key[1], key[2], key[3]}; *(u32x4*)(kl + q * 8 + 4) = (u32x4){key[4], key[5], key[6], key[7]};
    {
        float* sul = (float*)(kl + 1024); float* svl = (float*)(kl + 1536);
        float a[8], b[8];
#pragma unroll
        for (int r = 0; r < 8; ++r) { const int e = (int)(key[r] >> 18); a[r] = SU[e]; b[r] = SV[e]; }
        *(f32x4*)(sul + q * 8) = (f32x4){a[0], a[1], a[2], a[3]}; *(f32x4*)(sul + q * 8 + 4) = (f32x4){a[4], a[5], a[6], a[7]};
        *(f32x4*)(svl + q * 8) = (f32x4){b[0], b[1], b[2], b[3]}; *(f32x4*)(svl + q * 8 + 4) = (f32x4){b[4], b[5], b[6], b[7]};
    }
    float* wl = (float*)(kl + 512);
    {
        u32x4 ub[4][3];
#pragma unroll
        for (int b = 0; b < 4; ++b) {
            const unsigned char* r0 = U8 + (size_t)(kl[b] >> 18) * 768 + q * 16;
#pragma unroll
            for (int i = 0; i < 3; ++i) ub[b][i] = *(const u32x4*)(r0 + i * 256);
        }
#pragma unroll 1
        for (int j = 0; j < 128; j += 4) {
#pragma unroll
            for (int b = 0; b < 4; ++b) {
                const unsigned k0 = kl[j + b];
                const float su0 = ((const float*)(kl + 1024))[j + b], sv0 = ((const float*)(kl + 1536))[j + b];
                const v32h ua = __builtin_amdgcn_cvt_scalef32_pk32_f16_fp6((v6u32){ub[b][0][0], ub[b][0][1], ub[b][0][2], ub[b][0][3], ub[b][1][0], ub[b][1][1]}, 1.0f);
                const v32h uc = __builtin_amdgcn_cvt_scalef32_pk32_f16_fp6((v6u32){ub[b][1][2], ub[b][1][3], ub[b][2][0], ub[b][2][1], ub[b][2][2], ub[b][2][3]}, 1.0f);
                float a0 = 0.f, a1 = 0.f, a2 = 0.f, a3 = 0.f;
#pragma unroll
                for (int pp = 0; pp < 16; pp += 2) {
                    a0 = __builtin_amdgcn_fdot2((h16x2){ua[2 * pp], ua[2 * pp + 1]}, ash2(hh[pp >> 2][pp & 3]), a0, false);
                    a1 = __builtin_amdgcn_fdot2((h16x2){ua[2 * pp + 2], ua[2 * pp + 3]}, ash2(hh[(pp + 1) >> 2][(pp + 1) & 3]), a1, false);
                    a2 = __builtin_amdgcn_fdot2((h16x2){uc[2 * pp], uc[2 * pp + 1]}, ash2(hh[4 + (pp >> 2)][pp & 3]), a2, false);
                    a3 = __builtin_amdgcn_fdot2((h16x2){uc[2 * pp + 2], uc[2 * pp + 3]}, ash2(hh[4 + ((pp + 1) >> 2)][(pp + 1) & 3]), a3, false);
                }
                const int jn = j + b + 4 < 128 ? j + b + 4 : 127;
                const unsigned char* rn = U8 + (size_t)(kl[jn] >> 18) * 768 + q * 16;
#pragma unroll
                for (int i = 0; i < 3; ++i) ub[b][i] = *(const u32x4*)(rn + i * 256);
                const float d0 = sum16((a0 + a1) + (a2 + a3));
                const float w0 = (float)(k0 & 0x3FFFFu) * (1.0f / 262144.0f) * fgelu(d0 * su0) * sv0;
                if (q == 0) wl[j + b] = w0;
            }
        }
    }
    float ff[64];
#pragma unroll
    for (int e = 0; e < 64; ++e) ff[e] = 0.f;
    {
        u32x4 vb4[4][3];
#pragma unroll
        for (int b = 0; b < 4; ++b) {
            const unsigned char* r0 = V8 + (size_t)(kl[b] >> 18) * 768 + q * 16;
#pragma unroll
            for (int i = 0; i < 3; ++i) vb4[b][i] = *(const u32x4*)(r0 + i * 256);
        }
#pragma unroll 1
        for (int j = 0; j < 128; j += 4) {
#pragma unroll
            for (int b = 0; b < 4; ++b) {
                const float w = wl[j + b];
                {
                    const v32f va = __builtin_amdgcn_cvt_scalef32_pk32_f32_fp6((v6u32){vb4[b][0][0], vb4[b][0][1], vb4[b][0][2], vb4[b][0][3], vb4[b][1][0], vb4[b][1][1]}, 1.0f);
#pragma unroll
                    for (int e = 0; e < 32; ++e) ff[e] += w * va[e];
                }
                {
                    const v32f vc = __builtin_amdgcn_cvt_scalef32_pk32_f32_fp6((v6u32){vb4[b][1][2], vb4[b][1][3], vb4[b][2][0], vb4[b][2][1], vb4[b][2][2], vb4[b][2][3]}, 1.0f);
#pragma unroll
                    for (int e = 0; e < 32; ++e) ff[32 + e] += w * vc[e];
                }
                const int jn = j + b + 4 < 128 ? j + b + 4 : 127;
                const unsigned char* rn = V8 + (size_t)(kl[jn] >> 18) * 768 + q * 16;
#pragma unroll
                for (int i = 0; i < 3; ++i) vb4[b][i] = *(const u32x4*)(rn + i * 256);
            }
        }
    }
    float* fl = (float*)(smem + (tq >> 6) * 16384);
#pragma unroll
    for (int c = 0; c < 16; ++c) *(f32x4*)(fl + g * 1024 + q * 64 + c * 4) = (f32x4){ff[c * 4], ff[c * 4 + 1], ff[c * 4 + 2], ff[c * 4 + 3]};
    const int tokw = item * 16 + (tq >> 6) * 4;
#pragma unroll 1
    for (int tk = 0; tk < 4; ++tk) {
        const int tk_tok = tokw + tk;
        const float* mod = (const float*)(p.ws + OFF_MOD) + cond_of_tok(tk_tok) * 6144;
        const float* st = (const float*)(p.ws + OFF_STATS) + 2 * tk_tok; const float mu1 = st[0], rs1 = st[1];
        const float* vb = (const float*)(p.ws + OFF_VBUF) + (size_t)tk_tok * DM;
        const int k0 = lane * 16;
        float y[16]; float s = 0.f;
#pragma unroll
        for (int c = 0; c < 4; ++c) {
            const int k = k0 + c * 4;
            const f32x4 fv = *(const f32x4*)(fl + tk * 1024 + k);
            const f32x4 v = *(const f32x4*)(vb + k), lg = *(const f32x4*)(p.ln1_g + k), lbb = *(const f32x4*)(p.ln1_b + k), g2 = *(const f32x4*)(mod + 5120 + k);
#pragma unroll
            for (int j = 0; j < 4; ++j) { const float x1 = (v[j] - mu1) * rs1 * lg[j] + lbb[j]; const float yy = ALPHA_C * x1 + g2[j] * fv[j]; y[c * 4 + j] = yy; s += yy; }
        }
        s = sum64(s);
        const float mu = s * (1.f / 1024.f); float qq = 0.f;
#pragma unroll
        for (int e = 0; e < 16; ++e) { const float d = y[e] - mu; qq += d * d; }
        qq = sum64(qq);
        const float rstd = rsqrtf(qq * (1.f / 1024.f) + LN_EPS);
        float* o = p.out + (size_t)tk_tok * DM;
#pragma unroll
        for (int c = 0; c < 4; ++c) {
            const int k = k0 + c * 4;
            const f32x4 lg = *(const f32x4*)(p.ln2_g + k), lbb = *(const f32x4*)(p.ln2_b + k);
            f32x4 rr;
#pragma unroll
            for (int j = 0; j < 4; ++j) rr[j] = (y[c * 4 + j] - mu) * rstd * lg[j] + lbb[j];
            *(f32x4*)(o + k) = rr;
        }
    }
}

constexpr int SMEM_BYTES = 65536 + 8192 + 256 + 16;
__global__ void __launch_bounds__(256, 2) mega(P p) {
    __shared__ __attribute__((aligned(16))) char smem[SMEM_BYTES];
    const int nb = gridDim.x, bid = blockIdx.x;
    if (threadIdx.x == 0) *(uint4*)(smem + SMEM_BYTES - 16) = make_uint4(0u, 0u, 0u, 0u);
    __syncthreads();
    const XcdBarrier xb = xcd_barrier_post((unsigned*)(p.ws + OFF_BAR), (volatile LAS unsigned*)(smem + SMEM_BYTES - 16));
    for (int it = bid; it < 384 + 896 + 256 + 512; it += nb) {
        if (it < 384) ph_mod1(p, it, smem);
        else if (it < 384 + 896) ph_transpose<false>(p.w_in, (u16*)(p.ws + OFF_WIN_T), DM, DIN, it - 384, smem);
        else if (it < 384 + 896 + 256) ph_transpose<false>(p.w_out, (u16*)(p.ws + OFF_WOUT_T), DM, DM, it - 384 - 896, smem);
        else ph_transpose<true>(p.peer_wq, (u16*)(p.ws + OFF_WQ_T), DM, 2048, it - 384 - 896 - 256, smem);
    }
    for (int c = bid * 256 + threadIdx.x; c < 8 * 2 * 128 * 128 / 8; c += nb * 256) {
        const f32x4 a = *(const f32x4*)(p.peer_keys + (size_t)c * 8), b = *(const f32x4*)(p.peer_keys + (size_t)c * 8 + 4);
        ((u32x4*)(p.ws + OFF_KEYS16))[c] = (u32x4){cvt_pk_f16(a[0], a[1]), cvt_pk_f16(a[2], a[3]), cvt_pk_f16(b[0], b[1]), cvt_pk_f16(b[2], b[3])};
    }
    xcd_barrier(xb);
    ph_mod2(p, bid * 256 + threadIdx.x, nb * 256);
    for (int g = bid; g < NTOK / 32; g += nb) ph_make_h(p, g, smem);
    xcd_barrier(xb);
    gemm_phase<false, EPI1, 1>(p, (const u16*)(p.ws + OFF_HIN), DM, (const u16*)(p.ws + OFF_WIN_T), DM, 28, bid, nb, smem);
    xcd_barrier(xb);
    {
        const bool split = nb >= 384 && ((nb - 128) & 15) == 0;
        if (split) {
            if (bid < 128) {
                ph_hgrn(p, 512 + bid, smem); __syncthreads();
                ph_cvt_tables(p, bid * 4 + (threadIdx.x >> 6), 128 * 4, smem, 0, 11776);
            } else {
                const int b2 = bid - 128, nrest = nb - 128;
                ph_rg_tiles(p, b2 & 15, b2 >> 4, nrest >> 4, smem);
                for (int it = b2; it < 512; it += nrest) { ph_hgrn(p, it, smem); __syncthreads(); }
                ph_cvt_tables(p, b2 * 4 + (threadIdx.x >> 6), nrest * 4, smem, 11776, 2 * 16384);
            }
        } else {
            for (int it = bid; it < 640; it += nb) { ph_hgrn(p, it, smem); __syncthreads(); }
            for (int it = bid; it < 16 * 256; it += nb) ph_rg_tiles(p, it & 15, it >> 4, 256, smem);
            ph_cvt_tables(p, bid * 4 + (threadIdx.x >> 6), nb * 4, smem);
        }
    }
    xcd_barrier(xb);
    for (int it = bid; it < 512; it += nb) ph_combine(p, it, smem);
    xcd_barrier(xb);
    gemm_phase<false, EPI3, 1>(p, (const u16*)(p.ws + OFF_MIX), DM, (const u16*)(p.ws + OFF_WOUT_T), DM, 8, bid, nb, smem);
    xcd_barrier(xb);
    for (int it = bid; it < NTOK / 16; it += nb) ph_ln1stats(p, it);
    xcd_barrier(xb);
    gemm_phase<true, EPI4, 1>(p, (const u16*)(p.ws + OFF_H2), DM, (const u16*)(p.ws + OFF_WQ_T), DM, 16, bid, nb, smem);
    xcd_barrier(xb);
    {
        ph_topk_load_keys(p, bid & 7, smem);
        u32x4 qf[8];
        {
            const int t0 = threadIdx.x, lane = t0 & 63, wid = t0 >> 6;
            const u16* qrow = (const u16*)p.out + (size_t)((bid >> 3) * 64 + (wid & 1) * 32 + (lane & 31)) * 2048 + (bid & 7) * 256 + (wid >> 1) * 128 + (lane >> 5) * 8;
#pragma unroll
            for (int ks = 0; ks < 8; ++ks) qf[ks] = *(const u32x4*)(qrow + ks * 16);
        }
        __syncthreads();
        for (int it = bid; it < 2048; it += nb) ph_topk(p, it, it + nb < 2048 ? it + nb : it, qf, smem);
    }
    xcd_barrier(xb);
    for (int it = bid; it < NTOK / 16; it += nb) ph_peer_out(p, it, smem);
}

extern "C" void kernel_launch(void* const* d_in, const int* in_sizes, int n_in, void* d_out, int out_size, void* d_ws, size_t ws_size, hipStream_t stream) {
    P p{};
    const float** f = (const float**)&p;
    for (int i = 0; i < 27; ++i) f[i] = (const float*)d_in[i];
    p.out = (float*)d_out; p.ws = (char*)d_ws;
    static int grid_blocks = 0;
    if (!grid_blocks) {
        int dev = 0, cus = 0, per_cu = 0;
        (void)hipGetDevice(&dev);
        (void)hipDeviceGetAttribute(&cus, hipDeviceAttributeMultiprocessorCount, dev);
        (void)hipOccupancyMaxActiveBlocksPerMultiprocessor(&per_cu, mega, 256, 0);
        if (per_cu > 2) per_cu = 2;
        grid_blocks = cus * per_cu;
    }
    (void)hipMemsetAsync((char*)d_ws + OFF_BAR, 0, XCD_BAR_WORDS * 4, stream);
    void* args[] = {&p};
    hipError_t e = hipLaunchCooperativeKernel((void*)mega, dim3(grid_blocks), dim3(256), args, 0, stream);
    if (e != hipSuccess) fprintf(stderr, "cooperative launch failed: %s (grid %d)\n", hipGetErrorString(e), grid_blocks);
}
```

```cpp
#include <hip/hip_runtime.h>
#include <hip/hip_bf16.h>
#include <hip/hip_fp16.h>
#include <cstdint>
#include <cstdio>

constexpr int DM = 1024;
constexpr int NTOK = 16384;
constexpr int NCTX_TOK = 8192;
constexpr int NSEQ = 40;
constexpr int DIN = 3584;
constexpr int HGW = 512, RGW = 512;
constexpr float ALPHA_C = 1.189207115002721f;
constexpr float LN_EPS = 1e-5f, RMS_EPS = 1e-6f;
constexpr size_t MB = 1u << 20;
constexpr size_t OFF_MOD = 0, OFF_LB = 256 << 10, OFF_STATS = 512 << 10, OFF_TT = 172 * MB  , OFF_BAR = 768 << 10, OFF_TSC = 896 << 10  , OFF_MODP = 168 * MB  ;
constexpr size_t OFF_SQ = 16 * MB, OFF_VV = 32 * MB, OFF_MIX = 16 * MB;
constexpr size_t OFF_SG = 48 * MB, OFF_GGR = 64 * MB, OFF_H2 = 48 * MB;
constexpr size_t OFF_WIN_T = 1 * MB, OFF_WOUT_T = 9 * MB, OFF_WQ_T = 11 * MB, OFF_KEYS16 = 15 * MB;
constexpr size_t OFF_LOGF = 80 * MB  , OFF_VBUF = 80 * MB;
constexpr size_t OFF_XR = 144 * MB, OFF_IDX = 144 * MB  , OFF_GATE = 152 * MB;
constexpr size_t OFF_HF = 176 * MB  , OFF_HIN = 176 * MB  , OFF_U8 = 240 * MB  , OFF_V8 = 160 * MB  ;
constexpr size_t OUT_STHG = 16777216, OUT_STRG = 20971520;

typedef unsigned short u16;
typedef float f32x4 __attribute__((ext_vector_type(4)));
__device__ __forceinline__ float bf2f(u16 v) { return __uint_as_float(((unsigned)v) << 16); }
__device__ __forceinline__ u16 f2bf(float f) { unsigned u = __float_as_uint(f); u += 0x7FFFu + ((u >> 16) & 1u); return (u16)(u >> 16); }
__device__ __forceinline__ float sigmoidf_(float x) { return 1.0f / (1.0f + expf(-x)); }
__device__ __forceinline__ float siluf_(float x) { return x / (1.0f + expf(-x)); }
__device__ __forceinline__ float geluf_(float x) { return 0.5f * x * (1.0f + tanhf(0.7978845608028654f * (x + 0.044715f * x * x * x))); }
__device__ __forceinline__ float fsigmoid(float x) { return __builtin_amdgcn_rcpf(1.0f + __expf(-x)); }
__device__ __forceinline__ float fsilu(float x) { return x * fsigmoid(x); }
__device__ __forceinline__ float fgelu(float x) { return x * fsigmoid(1.5957691216057308f * (x + 0.044715f * x * x * x)); }
__device__ __forceinline__ float softplusf_(float x) { return fmaxf(x, 0.f) + log1pf(expf(-fabsf(x))); }

__device__ __forceinline__ int seq_of_tok(int t) { return t < NCTX_TOK ? (t >> 8) : 32 + ((t - NCTX_TOK) >> 10); }
__device__ __forceinline__ int cond_of_tok(int t) { return t < NCTX_TOK ? 0 : 1 + ((t - NCTX_TOK) >> 10); }

__device__ __forceinline__ int tid_opaque() { int t = threadIdx.x; asm volatile("" : "+v"(t)); return t; }
struct P {
    const float *x_prompt, *x_sample, *c, *state_hgrn, *state_rglru, *c_ctx, *w_ada, *b_ada, *w_in, *hgrn_lb, *hgrn_norm_g, *conv_w, *conv_b,
        *rg_wr, *rg_br, *rg_wi, *rg_bi, *rg_lam, *w_out, *ln1_g, *ln1_b, *peer_wq, *peer_keys, *peer_u, *peer_v, *ln2_g, *ln2_b;
    float* out; char* ws;
};
__device__ __forceinline__ const float* xrow(const P& p, int t) { return t < NCTX_TOK ? p.x_prompt + (size_t)t * DM : p.x_sample + (size_t)(t - NCTX_TOK) * DM; }

#define XB_TMO      128
#define XB_XCNT(j)  (256  + 64 * (j))
#define XB_XSUB(j)  (1280 + 64 * (j))
#define XB_XGEN(j)  (2304 + 64 * (j))
#define XB_TOP      3328
#define XB_TOPGEN   3392
#define XCD_BAR_WORDS 3456
#define XB_SPIN_CAP (1u << 22)
#define LAS __attribute__((address_space(3)))
__device__ __forceinline__ unsigned xb_ld(unsigned* p) { return __hip_atomic_load(p, __ATOMIC_RELAXED, __HIP_MEMORY_SCOPE_AGENT); }
__device__ __forceinline__ unsigned xb_add(unsigned* p, unsigned v) { return __hip_atomic_fetch_add(p, v, __ATOMIC_RELAXED, __HIP_MEMORY_SCOPE_AGENT); }
__device__ __forceinline__ unsigned xb_xcc_id() { return (unsigned)__builtin_amdgcn_s_getreg((3 << 11) | 20) & 0xFu; }
#define XB_SPIN(cond, bar) do { unsigned _sp = 0; while (cond) { __builtin_amdgcn_s_sleep(1); \
    if ((++_sp & 255u) == 0u) { if (xb_ld(&(bar)[XB_TMO])) break; if (_sp > XB_SPIN_CAP) { atomicAdd(&(bar)[XB_TMO], 1u); break; } } } } while (0)
struct XcdBarrier { unsigned* bar; unsigned x; volatile LAS unsigned* st; };
__device__ __forceinline__ XcdBarrier xcd_barrier_post(unsigned* bar, volatile LAS unsigned* st) {
    XcdBarrier b; b.bar = bar; b.x = xb_xcc_id(); b.st = st;
    if (threadIdx.x == 0) (void)xb_add(&bar[XB_XCNT(b.x)], 1u);
    return b;
}
__device__ __forceinline__ void xcd_barrier_complete(unsigned* bar, unsigned x, unsigned& nloc, unsigned& nx) {
    const unsigned G = gridDim.x * gridDim.y * gridDim.z;
    unsigned sum, cnt, mine, sp = 0u;
    for (;;) {
        sum = 0u; cnt = 0u; mine = 0u;
#pragma unroll
        for (unsigned j = 0; j < 16; ++j) { const unsigned c = xb_ld(&bar[XB_XCNT(j)]); sum += c; cnt += (c > 0u) ? 1u : 0u; mine = (j == x) ? c : mine; }
        if (sum == G) break;
        __builtin_amdgcn_s_sleep(1);
        if ((++sp & 255u) == 0u) { if (xb_ld(&bar[XB_TMO])) break; if (sp > XB_SPIN_CAP) { atomicAdd(&bar[XB_TMO], 1u); break; } }
    }
    nloc = mine > 0u ? mine : 1u; nx = cnt > 0u ? cnt : 1u;
}
__device__ __forceinline__ void xcd_barrier(const XcdBarrier& b) {
    asm volatile("s_waitcnt vmcnt(0)" ::: "memory");
    __syncthreads();
    if (threadIdx.x == 0) {
        unsigned* bar = b.bar;
        __builtin_amdgcn_s_waitcnt(0);
        unsigned nloc = b.st[0], nx = b.st[1];
        if (nloc == 0u) { xcd_barrier_complete(bar, b.x, nloc, nx); b.st[0] = nloc; b.st[1] = nx; }
        const unsigned old = xb_add(&bar[XB_XSUB(b.x)], 1u);
        const unsigned gen = old / nloc;
        if (old + 1u == (gen + 1u) * nloc) {
            __builtin_amdgcn_fence(__ATOMIC_RELEASE, "agent");
            asm volatile("s_waitcnt vmcnt(0)" ::: "memory");
            const unsigned og = xb_add(&bar[XB_TOP], 1u);
            const unsigned tg = og / nx;
            if (og + 1u == (tg + 1u) * nx) xb_add(&bar[XB_TOPGEN], 1u);
            else XB_SPIN(xb_ld(&bar[XB_TOPGEN]) == tg, bar);
            __builtin_amdgcn_fence(__ATOMIC_ACQUIRE, "agent");
            xb_add(&bar[XB_XGEN(b.x)], 1u);
            asm volatile("s_waitcnt vmcnt(0)" ::: "memory");
        } else {
            XB_SPIN(xb_ld(&bar[XB_XGEN(b.x)]) == gen, bar);
            __builtin_amdgcn_fence(__ATOMIC_ACQUIRE, "agent");
            asm volatile("s_waitcnt vmcnt(0)" ::: "memory");
        }
    }
    __syncthreads();
}

__device__ __forceinline__ void xcd_local_barrier(const XcdBarrier& b) {
    asm volatile("s_waitcnt vmcnt(0)" ::: "memory");
    __syncthreads();
    if (threadIdx.x == 0) {
        unsigned* bar = b.bar;
        __builtin_amdgcn_s_waitcnt(0);
        const unsigned nloc = b.st[0];
        const unsigned old = xb_add(&bar[XB_XSUB(b.x)], 1u);
        const unsigned gen = old / nloc;
        if (old + 1u == (gen + 1u) * nloc) {
            __builtin_amdgcn_fence(__ATOMIC_ACQUIRE, "agent");
            xb_add(&bar[XB_XGEN(b.x)], 1u);
            asm volatile("s_waitcnt vmcnt(0)" ::: "memory");
        } else {
            XB_SPIN(xb_ld(&bar[XB_XGEN(b.x)]) == gen, bar);
            __builtin_amdgcn_fence(__ATOMIC_ACQUIRE, "agent");
            asm volatile("s_waitcnt vmcnt(0)" ::: "memory");
        }
    }
    __syncthreads();
}

template <int CTRL> __device__ __forceinline__ float dpp_f(float v) { return __builtin_bit_cast(float, __builtin_amdgcn_update_dpp(0, __builtin_bit_cast(int, v), CTRL, 0xF, 0xF, true)); }
__device__ __forceinline__ float sum16(float v) { v += dpp_f<0xB1>(v); v += dpp_f<0x4E>(v); v += dpp_f<0x141>(v); v += dpp_f<0x140>(v); return v; }
__device__ __forceinline__ float sum64(float v) { v = sum16(v); v += __shfl_xor(v, 16); v += __shfl_xor(v, 32); return v; }
__device__ __forceinline__ float max64(float v) {
    v = fmaxf(v, dpp_f<0xB1>(v)); v = fmaxf(v, dpp_f<0x4E>(v)); v = fmaxf(v, dpp_f<0x141>(v)); v = fmaxf(v, dpp_f<0x140>(v));
    v = fmaxf(v, __shfl_xor(v, 16)); v = fmaxf(v, __shfl_xor(v, 32)); return v;
}
typedef float f32x2 __attribute__((ext_vector_type(2)));
__device__ __forceinline__ void ph_mod1(const P& p, int item, char* smem) {
    const int cgp = item % 48, ks = item / 48;
    float* sc = (float*)smem;
    float* red = sc + 9 * 128;
    const int t = tid_opaque(), lane = t & 63, w = t >> 6;
    for (int i = t; i < 9 * 128; i += 256) { const int r = i >> 7, k = ks * 128 + (i & 127); sc[i] = siluf_(r == 0 ? p.c_ctx[k] : p.c[(size_t)(r - 1) * DM + k]); }
    const float* wp = p.w_ada + (size_t)(ks * 128 + w * 32) * 6144 + cgp * 128 + lane * 2;
    f32x2 wv[32];
#pragma unroll
    for (int k = 0; k < 32; ++k) wv[k] = *(const f32x2*)(wp + (size_t)k * 6144);
    __syncthreads();
    f32x2 acc[9];
#pragma unroll
    for (int r = 0; r < 9; ++r) acc[r] = (f32x2){0.f, 0.f};
#pragma unroll
    for (int k = 0; k < 32; ++k) {
#pragma unroll
        for (int r = 0; r < 9; ++r) acc[r] += wv[k] * sc[r * 128 + w * 32 + k];
    }
#pragma unroll
    for (int r = 0; r < 9; ++r) *(f32x2*)(red + (w * 9 + r) * 128 + lane * 2) = acc[r];
    __syncthreads();
    float* part = (float*)(p.ws + OFF_MODP) + (size_t)ks * 9 * 6144;
    for (int i = t; i < 9 * 128; i += 256) {
        const int r = i >> 7, c = i & 127;
        part[r * 6144 + cgp * 128 + c] = red[(0 * 9 + r) * 128 + c] + red[(1 * 9 + r) * 128 + c] + red[(2 * 9 + r) * 128 + c] + red[(3 * 9 + r) * 128 + c];
    }
    if (item == 0) {
        float* lb = (float*)(p.ws + OFF_LB);
        for (int i = t; i < 1024; i += 256) {
            int d = i >> 9, ch = i & 511;
            float l0 = p.hgrn_lb[(d * 2 + 0) * 512 + ch], l1 = p.hgrn_lb[(d * 2 + 1) * 512 + ch];
            float m = fmaxf(l0, l1); float e0 = expf(l0 - m), e1 = expf(l1 - m);
            lb[i] = e0 / (e0 + e1);
        }
    }
    __syncthreads();
}
__device__ __forceinline__ void ph_mod2(const P& p, int gtid, int gthreads) {
    float* mod = (float*)(p.ws + OFF_MOD); const float* part = (const float*)(p.ws + OFF_MODP);
    for (int i = gtid; i < 9 * 6144; i += gthreads) {
        float a = p.b_ada[i % 6144];
#pragma unroll
        for (int ks = 0; ks < 8; ++ks) a += part[(size_t)ks * 9 * 6144 + i];
        mod[i] = a;
    }
}

typedef __bf16 b16x8 __attribute__((ext_vector_type(8)));
typedef _Float16 h16x8 __attribute__((ext_vector_type(8)));
typedef float f32x16 __attribute__((ext_vector_type(16)));
typedef unsigned u32x4 __attribute__((ext_vector_type(4)));
typedef unsigned u32x2 __attribute__((ext_vector_type(2)));
__device__ __forceinline__ unsigned cvt_pk_bf16(float lo, float hi) { unsigned r; asm("v_cvt_pk_bf16_f32 %0, %1, %2" : "=v"(r) : "v"(lo), "v"(hi)); return r; }
__device__ __forceinline__ unsigned cvt_pk_f16(float lo, float hi) { typedef _Float16 h2 __attribute__((ext_vector_type(2))); h2 v; v.x = (_Float16)lo; v.y = (_Float16)hi; return __builtin_bit_cast(unsigned, v); }
template <bool F16> __device__ __forceinline__ f32x16 mfma32(u32x4 a, u32x4 b, f32x16 c) {
    if constexpr (F16) return __builtin_amdgcn_mfma_f32_32x32x16_f16(__builtin_bit_cast(h16x8, a), __builtin_bit_cast(h16x8, b), c, 0, 0, 0);
    else return __builtin_amdgcn_mfma_f32_32x32x16_bf16(__builtin_bit_cast(b16x8, a), __builtin_bit_cast(b16x8, b), c, 0, 0, 0);
}
template <bool F16> __device__ __forceinline__ f32x4 mfma16(u32x4 a, u32x4 b, f32x4 c) {
    if constexpr (F16) return __builtin_amdgcn_mfma_f32_16x16x32_f16(__builtin_bit_cast(h16x8, a), __builtin_bit_cast(h16x8, b), c, 0, 0, 0);
    else return __builtin_amdgcn_mfma_f32_16x16x32_bf16(__builtin_bit_cast(b16x8, a), __builtin_bit_cast(b16x8, b), c, 0, 0, 0);
}
__device__ __forceinline__ int lds_off(int row, int c) { return row * 128 + ((c ^ ((row >> 1) & 7)) << 4); }

template <bool F16, class EPI, int SHAPE = 0>
__device__ __forceinline__ void gemm_phase(const P& p, const u16* A16, int lda, const u16* Bt, int K, int NTN, int bid, int nb, char* smem) {
    EPI epi;
    const int t = tid_opaque(), lane = t & 63, wid = t >> 6, wm = wid >> 1, wn = wid & 1, r = lane & 31, h = lane >> 5;
    const int srow = t >> 3, kc = t & 7;
    const int ntiles = 16 * NTN, lstep = nb >> 3;
    int lt = bid >> 3;
    if (lt >= ntiles) return;
    u32x4 ra0[4], rb0[4], ra1[4], rb1[4];
    const __amdgpu_buffer_rsrc_t rsA = __builtin_amdgcn_make_buffer_rsrc((void*)A16, 0, 0x7FFFFFFF, 0x00020000);
    const __amdgpu_buffer_rsrc_t rsB = __builtin_amdgcn_make_buffer_rsrc((void*)Bt, 0, 0x7FFFFFFF, 0x00020000);
    int voA, voB;
    auto set_tile = [&](int l) {
        const int row0 = ((bid & 7) * 16 + l / NTN) * 128, col0 = (l % NTN) * 128;
        voA = ((row0 + srow) * lda + kc * 8) * 2; voB = ((col0 + srow) * K + kc * 8) * 2;
    };
    auto load_regs = [&](u32x4 (&ra)[4], u32x4 (&rb)[4], int k0) {
#pragma unroll
        for (int i = 0; i < 4; ++i) {
            ra[i] = __builtin_amdgcn_raw_buffer_load_b128(rsA, voA, (32 * i * lda + k0) * 2, 0);
            rb[i] = __builtin_amdgcn_raw_buffer_load_b128(rsB, voB, (32 * i * K + k0) * 2, 0);
        }
    };
    auto store_lds = [&](const u32x4 (&ra)[4], const u32x4 (&rb)[4], char* Ab, char* Bb) {
#pragma unroll
        for (int i = 0; i < 4; ++i) { *(u32x4*)(Ab + lds_off(srow + 32 * i, kc)) = ra[i]; *(u32x4*)(Bb + lds_off(srow + 32 * i, kc)) = rb[i]; }
    };
    char* A0 = smem; char* B0 = smem + 16384; char* A1 = smem + 32768; char* B1 = smem + 49152;
    const int nk = K / 64;
    set_tile(lt);
    load_regs(ra0, rb0, 0); load_regs(ra1, rb1, 64);
#pragma unroll 1
    for (; lt < ntiles; lt += lstep) {
        const int row0 = ((bid & 7) * 16 + lt / NTN) * 128, col0 = (lt % NTN) * 128;
        f32x16 acc[2][2]; f32x4 acc16[4][4];
        if constexpr (SHAPE == 0) {
#pragma unroll
        for (int i = 0; i < 2; ++i)
#pragma unroll
            for (int j = 0; j < 2; ++j)
#pragma unroll
                for (int e = 0; e < 16; ++e) acc[i][j][e] = 0.f;
        } else {
#pragma unroll
        for (int i = 0; i < 4; ++i)
#pragma unroll
            for (int j = 0; j < 4; ++j) acc16[i][j] = (f32x4){0.f, 0.f, 0.f, 0.f};
        }
        auto compute_store = [&](const char* Ab, const char* Bb, const u32x4 (&ra)[4], const u32x4 (&rb)[4], char* An, char* Bn) {
            if constexpr (SHAPE == 1) {
                const int l15 = lane & 15, l4 = lane >> 4;
#pragma unroll
                for (int ks = 0; ks < 2; ++ks) {
                    u32x4 af[4], bf[4];
#pragma unroll
                    for (int i = 0; i < 4; ++i) {
                        af[i] = *(const u32x4*)(Ab + lds_off(wm * 64 + i * 16 + l15, ks * 4 + l4));
                        bf[i] = *(const u32x4*)(Bb + lds_off(wn * 64 + i * 16 + l15, ks * 4 + l4));
                    }
#pragma unroll
                    for (int mh = 0; mh < 2; ++mh) {
#pragma unroll
                        for (int i = 2 * mh; i < 2 * mh + 2; ++i)
#pragma unroll
                            for (int j = 0; j < 4; ++j) acc16[i][j] = mfma16<F16>(af[i], bf[j], acc16[i][j]);
                        const int ci = ks * 2 + mh;
                        *(u32x4*)(An + lds_off(srow + 32 * ci, kc)) = ra[ci]; *(u32x4*)(Bn + lds_off(srow + 32 * ci, kc)) = rb[ci];
                        __builtin_amdgcn_sched_barrier(0);
                    }
                }
                return;
            }
#pragma unroll
            for (int ks = 0; ks < 4; ++ks) {
                u32x4 af[2], bf[2];
#pragma unroll
                for (int i = 0; i < 2; ++i) {
                    af[i] = *(const u32x4*)(Ab + lds_off(wm * 64 + i * 32 + r, ks * 2 + h));
                    bf[i] = *(const u32x4*)(Bb + lds_off(wn * 64 + i * 32 + r, ks * 2 + h));
                }
#pragma unroll
                for (int i = 0; i < 2; ++i)
#pragma unroll
                    for (int j = 0; j < 2; ++j) acc[i][j] = mfma32<F16>(af[i], bf[j], acc[i][j]);
                *(u32x4*)(An + lds_off(srow + 32 * ks, kc)) = ra[ks]; *(u32x4*)(Bn + lds_off(srow + 32 * ks, kc)) = rb[ks];
                __builtin_amdgcn_sched_barrier(0);
            }
        };
        store_lds(ra0, rb0, A0, B0);
        __syncthreads();
#pragma unroll 1
        for (int kt = 0; kt < nk; kt += 2) {
            load_regs(ra0, rb0, (kt + 2 < nk ? kt + 2 : nk - 1) * 64);
            compute_store(A0, B0, ra1, rb1, A1, B1);
            __syncthreads();
            load_regs(ra1, rb1, (kt + 3 < nk ? kt + 3 : nk - 1) * 64);
            compute_store(A1, B1, ra0, rb0, A0, B0);
            __syncthreads();
        }
        const int ecc = (lane & 15) * 4, ecg = col0 + wn * 64 + ecc, erb = row0 + wm * 64 + (lane >> 4);
        const f32x4 ecst = epi.col(p, erb, ecg);
        f32x4 erw[16];
#pragma unroll
        for (int i = 0; i < 16; ++i) erw[i] = epi.row(p, erb + 4 * i, ecg);
        set_tile(lt + lstep < ntiles ? lt + lstep : lt);
        load_regs(ra0, rb0, 0); load_regs(ra1, rb1, 64);
        float* eb = (float*)(smem + wid * 16384);
        if constexpr (SHAPE == 0) {
#pragma unroll
        for (int i = 0; i < 2; ++i)
#pragma unroll
            for (int j = 0; j < 2; ++j)
#pragma unroll
                for (int e = 0; e < 16; ++e) eb[(i * 32 + (e & 3) + 8 * (e >> 2) + 4 * h) * 64 + j * 32 + r] = acc[i][j][e];
        } else {
#pragma unroll
        for (int i = 0; i < 4; ++i)
#pragma unroll
            for (int j = 0; j < 4; ++j)
#pragma unroll
                for (int e = 0; e < 4; ++e) eb[(i * 16 + (lane >> 4) * 4 + e) * 64 + j * 16 + (lane & 15)] = acc16[i][j][e];
        }
        {
#pragma unroll
            for (int i = 0; i < 16; ++i) {
                const int rr = (lane >> 4) + 4 * i;
                const f32x4 v = *(const f32x4*)(eb + rr * 64 + ecc);
                epi.fin(p, row0 + wm * 64 + rr, ecg, v, ecst, erw[i]);
            }
        }
        __syncthreads();
    }
}

__device__ __forceinline__ void ph_make_h(const P& p, int grp, char* smem) {
    float* ml = (float*)smem;
    const int t = tid_opaque();
    const int r = cond_of_tok(grp * 32);
    const float* part = (const float*)(p.ws + OFF_MODP) + (size_t)r * 6144;
    auto ld4 = [&](int g4, f32x4 (&a)[4], f32x4 (&b)[4]) {
#pragma unroll
        for (int i = 0; i < 4; ++i) {
            const int c = grp * 4096 + t + 256 * (g4 * 4 + i);
            const float* xr_ = xrow(p, c >> 7) + (c & 127) * 8;
            a[i] = *(const f32x4*)xr_; b[i] = *(const f32x4*)(xr_ + 4);
        }
    };
    f32x4 Pa[4], Pb[4], Qa[4], Qb[4];
    ld4(0, Pa, Pb);
#pragma unroll
    for (int i = 0; i < 8; ++i) {
        const int c = t + 256 * i;
        float a = p.b_ada[c];
#pragma unroll
        for (int ks = 0; ks < 8; ++ks) a += part[(size_t)ks * 9 * 6144 + c];
        ml[c] = a;
    }
    ld4(1, Qa, Qb);
    __syncthreads();
    u32x4* dst = (u32x4*)(p.ws + OFF_HIN);
    auto st4 = [&](int g4, const f32x4 (&a)[4], const f32x4 (&b)[4]) {
#pragma unroll
        for (int i = 0; i < 4; ++i) {
            const int c = grp * 4096 + t + 256 * (g4 * 4 + i);
            const int k = (c & 127) * 8;
            const f32x4 sh0 = *(const f32x4*)(ml + k), sh1 = *(const f32x4*)(ml + k + 4), sc0 = *(const f32x4*)(ml + 1024 + k), sc1 = *(const f32x4*)(ml + 1024 + k + 4);
            const f32x4 v0 = a[i] * (sc0 + 1.0f) + sh0, v1 = b[i] * (sc1 + 1.0f) + sh1;
            dst[c] = (u32x4){cvt_pk_bf16(v0[0], v0[1]), cvt_pk_bf16(v0[2], v0[3]), cvt_pk_bf16(v1[0], v1[1]), cvt_pk_bf16(v1[2], v1[3])};
        }
    };
    __builtin_amdgcn_sched_barrier(0);
    st4(0, Pa, Pb);
    __builtin_amdgcn_sched_barrier(0);
    ld4(2, Pa, Pb);
    __builtin_amdgcn_sched_barrier(0);
    st4(1, Qa, Qb);
    __builtin_amdgcn_sched_barrier(0);
    ld4(3, Qa, Qb);
    __builtin_amdgcn_sched_barrier(0);
    st4(2, Pa, Pb);
    __builtin_amdgcn_sched_barrier(0);
    st4(3, Qa, Qb);
    __syncthreads();
}

__device__ __forceinline__ u32x2 pk4_bf16(f32x4 v) { return (u32x2){cvt_pk_bf16(v[0], v[1]), cvt_pk_bf16(v[2], v[3])}; }
struct EPI1 {
  __device__ __forceinline__ f32x4 col(const P& p, int t0, int n) const {
    const int part = n >> 9, c = n & 511;
    if (part == 2 || part == 3) return *(const f32x4*)((const float*)(p.ws + OFF_LB) + (part - 2) * 512 + c);
    return (f32x4){0.f, 0.f, 0.f, 0.f}; }
  __device__ __forceinline__ f32x4 row(const P& p, int t, int n) const { return (f32x4){0.f, 0.f, 0.f, 0.f}; }
  __device__ __forceinline__ void fin(const P& p, int t, int n, f32x4 z, f32x4 cst, f32x4 rw) const {
    const int part = n >> 9, c = n & 511; const size_t o = (size_t)t * 512 + c;
    if (part == 0) { f32x4 y; for (int j = 0; j < 4; ++j) y[j] = fsilu(z[j]); *(u32x2*)((u16*)(p.ws + OFF_SQ) + o) = pk4_bf16(y); }
    else if (part == 1) *(u32x2*)((u16*)(p.ws + OFF_VV) + o) = pk4_bf16(z);
    else if (part == 2 || part == 3) {
        const f32x4 l = cst; f32x4 y;
        for (int j = 0; j < 4; ++j) y[j] = __logf(l[j] + (1.f - l[j]) * fsigmoid(z[j]));
        *(u32x2*)((u16*)(p.ws + OFF_LOGF + (size_t)(part - 2) * 32 * MB) + o) = (u32x2){cvt_pk_f16(y[0], y[1]), cvt_pk_f16(y[2], y[3])};
    }
    else if (part == 4) { f32x4 y; for (int j = 0; j < 4; ++j) y[j] = fsilu(z[j]); *(u32x2*)((u16*)(p.ws + OFF_SG) + o) = pk4_bf16(y); }
    else if (part == 5) *(u32x2*)((u16*)(p.ws + OFF_XR) + o) = pk4_bf16(z);
    else { f32x4 y; for (int j = 0; j < 4; ++j) y[j] = fgelu(z[j]); *(u32x2*)((u16*)(p.ws + OFF_GGR) + o) = pk4_bf16(y); } } };
__device__ __forceinline__ f32x4 h4_of(unsigned w0, unsigned w1) { typedef _Float16 h2 __attribute__((ext_vector_type(2))); const h2 a = __builtin_bit_cast(h2, w0), b = __builtin_bit_cast(h2, w1); return (f32x4){(float)a.x, (float)a.y, (float)b.x, (float)b.y}; }
__device__ __forceinline__ f32x4 h4_lo(u32x4 w) { const unsigned w0 = w[0], w1 = w[1]; return h4_of(w0, w1); }
__device__ __forceinline__ f32x4 h4_hi(u32x4 w) { const unsigned w2 = w[2], w3 = w[3]; return h4_of(w2, w3); }
struct EPI3 {
  __device__ __forceinline__ f32x4 col(const P& p, int t0, int n) const { return *(const f32x4*)((const float*)(p.ws + OFF_MOD) + cond_of_tok(t0) * 6144 + 2048 + n); }
  __device__ __forceinline__ f32x4 row(const P& p, int t, int n) const { return *(const f32x4*)(xrow(p, t) + n); }
  __device__ __forceinline__ void fin(const P& p, int t, int n, f32x4 a, f32x4 g1, f32x4 x) const {
    const f32x4 y = x * ALPHA_C + g1 * a;
    *(u32x2*)((u16*)(p.ws + OFF_VBUF) + (size_t)t * DM + n) = (u32x2){cvt_pk_f16(y[0], y[1]), cvt_pk_f16(y[2], y[3])}; } };
struct EPI4 {
  __device__ __forceinline__ f32x4 col(const P& p, int t0, int n) const { return (f32x4){0.f, 0.f, 0.f, 0.f}; }
  __device__ __forceinline__ f32x4 row(const P& p, int t, int n) const { return (f32x4){0.f, 0.f, 0.f, 0.f}; }
  __device__ __forceinline__ void fin(const P& p, int t, int n, f32x4 a, f32x4 cst, f32x4 rw) const {
    *(u32x2*)((u16*)p.out + (size_t)t * 2048 + n) = (u32x2){cvt_pk_f16(a[0], a[1]), cvt_pk_f16(a[2], a[3])}; } };
__device__ __forceinline__ float x1_of(const P& p, int t, int k) {
    const float* st = (const float*)(p.ws + OFF_STATS) + 2 * t;
    return ((float)((const _Float16*)(p.ws + OFF_VBUF))[(size_t)t * DM + k] - st[0]) * st[1] * p.ln1_g[k] + p.ln1_b[k];
}

template <bool F16>
__device__ __forceinline__ void ph_transpose(const float* src, u16* dst, int K, int N, int item, char* smem) {
    float (*tile)[65] = (float (*)[65])smem;
    const int ntn = N / 64, kt = item / ntn, nt = item % ntn, t = tid_opaque();
#pragma unroll
    for (int i = 0; i < 4; ++i) {
        const int k = (t >> 4) + 16 * i, n4 = (t & 15) * 4;
        const f32x4 v = *(const f32x4*)(src + (size_t)(kt * 64 + k) * N + nt * 64 + n4);
        tile[k][n4] = v[0]; tile[k][n4 + 1] = v[1]; tile[k][n4 + 2] = v[2]; tile[k][n4 + 3] = v[3];
    }
    __syncthreads();
    const int n = t >> 2, kq = (t & 3) * 16;
    unsigned w[8];
#pragma unroll
    for (int j = 0; j < 8; ++j) {
        const float a = tile[kq + 2 * j][n], b = tile[kq + 2 * j + 1][n];
        w[j] = F16 ? cvt_pk_f16(a, b) : cvt_pk_bf16(a, b);
    }
    u16* d = dst + (size_t)(nt * 64 + n) * K + kt * 64 + kq;
    *(u32x4*)d = (u32x4){w[0], w[1], w[2], w[3]}; *(u32x4*)(d + 8) = (u32x4){w[4], w[5], w[6], w[7]};
    __syncthreads();
}

__device__ __forceinline__ int hg_off(int row, int d) { return row * 256 + ((((d >> 3) ^ (row & 15)) << 4) | ((d & 7) << 1)); }
__device__ __forceinline__ void ph_hgrn(const P& p, int item, char* smem) {
    const int dir = item & 1, head = (item >> 1) & 3, seq = item >> 3;
    const int T = seq < 32 ? 256 : 1024;
    const int tok0 = seq < 32 ? seq * 256 : NCTX_TOK + (seq - 32) * 1024;
    const int t = tid_opaque(), lane = t & 63, w = t >> 6, r = lane & 31, hq = lane >> 5;
    const int pd = t & 127, ph = t >> 7;
    char* qd = smem; char* kd = smem + 8192; char* keT = smem + 16384; char* vT = smem + 16384 + 10240;
    float* decay = (float*)(smem + 16384 + 20480); float* tot = decay + 128;
    const u16* sq = (const u16*)(p.ws + OFF_SQ);
    const u16* vv = (const u16*)(p.ws + OFF_VV);
    const _Float16* lg = (const _Float16*)(p.ws + OFF_LOGF + (size_t)dir * 32 * MB);
    u16* od = (u16*)p.out + (size_t)dir * 8388608;
    f32x16 S[4];
    if (seq >= 32) {
        const float* s0 = p.state_hgrn + ((size_t)((seq - 32) * 2 + dir) * 4 + head) * 16384;
#pragma unroll
        for (int db = 0; db < 4; ++db)
#pragma unroll
            for (int e = 0; e < 16; ++e) S[db][e] = s0[(size_t)(32 * db + (e & 3) + 8 * (e >> 2) + 4 * hq) * 128 + 32 * w + r];
    } else {
#pragma unroll
        for (int db = 0; db < 4; ++db)
#pragma unroll
            for (int e = 0; e < 16; ++e) S[db][e] = 0.f;
    }
    const int nc = T / 32;
    char* rawq = smem + 16384 + 20480 + 2048;
    char* rawv = rawq + 8192;
    const int phu = __builtin_amdgcn_readfirstlane(ph);
    const int wc = t >> 3, wg = t & 7;
    float plg[16]; u32x4 pq0, pq1, pv0, pv1;
    auto prefetch = [&](int n) {
#pragma unroll
        for (int i = 0; i < 16; ++i) {
            const int sidx = n * 32 + phu * 16 + i;
            const int tok = tok0 + (dir ? T - 1 - sidx : sidx);
            plg[i] = (float)(lg + (size_t)tok * 512 + head * 128)[pd];
        }
        const int sidx = n * 32 + wc;
        const size_t o = (size_t)(tok0 + (dir ? T - 1 - sidx : sidx)) * 512 + head * 128 + wg * 16;
        pq0 = *(const u32x4*)(sq + o); pq1 = *(const u32x4*)(sq + o + 8);
        pv0 = *(const u32x4*)(vv + o); pv1 = *(const u32x4*)(vv + o + 8);
    };
    prefetch(0);
    for (int n = 0; n < nc; ++n) {
        *(u32x4*)(rawq + wc * 256 + wg * 32) = pq0; *(u32x4*)(rawq + wc * 256 + wg * 32 + 16) = pq1;
        *(u32x4*)(rawv + wc * 256 + wg * 32) = pv0; *(u32x4*)(rawv + wc * 256 + wg * 32 + 16) = pv1;
        float cs[16], fk[16]; float run = 0.f;
#pragma unroll
        for (int i = 0; i < 16; ++i) { run += plg[i]; cs[i] = run; fk[i] = 1.f - __expf(plg[i]); }
        tot[ph * 128 + pd] = run;
        prefetch(n + 1 < nc ? n + 1 : n);
        __syncthreads();
        const float off = ph ? tot[pd] : 0.f;
        const float blast = tot[pd] + tot[128 + pd];
        const float dcy = __expf(blast);
        if (ph == 0) decay[pd] = dcy;
        unsigned ke[8], vt[8];
        u16 qr[16], vr[16];
#pragma unroll
        for (int i = 0; i < 16; ++i) { const int c = ph * 16 + i; qr[i] = *(const u16*)(rawq + c * 256 + pd * 2); vr[i] = *(const u16*)(rawv + c * 256 + pd * 2); }
        __builtin_amdgcn_sched_barrier(0);
#pragma unroll
        for (int i = 0; i < 16; i += 2) {
            float kev[2];
#pragma unroll
            for (int j = 0; j < 2; ++j) {
                const int c = ph * 16 + i + j;
                const float eb = __expf(off + cs[i + j]);
                const float kdv = fk[i + j] * __builtin_amdgcn_rcpf(eb);
                kev[j] = kdv * dcy;
                *(u16*)(qd + hg_off(c, pd)) = f2bf(bf2f(qr[i + j]) * eb);
                *(u16*)(kd + hg_off(c, pd)) = f2bf(kdv);
            }
            ke[i >> 1] = cvt_pk_bf16(kev[0], kev[1]);
            vt[i >> 1] = (unsigned)vr[i] | ((unsigned)vr[i + 1] << 16);
        }
        *(u32x4*)(keT + pd * 80 + ph * 32) = (u32x4){ke[0], ke[1], ke[2], ke[3]};
        *(u32x4*)(keT + pd * 80 + ph * 32 + 16) = (u32x4){ke[4], ke[5], ke[6], ke[7]};
        *(u32x4*)(vT + pd * 80 + ph * 32) = (u32x4){vt[0], vt[1], vt[2], vt[3]};
        *(u32x4*)(vT + pd * 80 + ph * 32 + 16) = (u32x4){vt[4], vt[5], vt[6], vt[7]};
        __syncthreads();
        f32x16 att;
#pragma unroll
        for (int e = 0; e < 16; ++e) att[e] = 0.f;
        {
            u32x4 ka[8], qb[8];
#pragma unroll
            for (int ks = 0; ks < 8; ++ks) { const int off16 = r * 256 + (((2 * ks + hq) ^ (r & 15)) << 4); ka[ks] = *(const u32x4*)(kd + off16); qb[ks] = *(const u32x4*)(qd + off16); }
            __builtin_amdgcn_sched_barrier(0);
#pragma unroll
            for (int ks = 0; ks < 8; ++ks) att = mfma32<false>(ka[ks], qb[ks], att);
        }
#pragma unroll
        for (int e = 0; e < 16; ++e) { const int srow = (e & 3) + 8 * (e >> 2) + 4 * hq; att[e] = (srow <= r) ? att[e] : 0.f; }
        f32x16 o;
#pragma unroll
        for (int e = 0; e < 16; ++e) o[e] = 0.f;
#pragma unroll
        for (int sp = 0; sp < 2; ++sp) {
            const u32x4 pa = (u32x4){cvt_pk_bf16(att[8 * sp], att[8 * sp + 1]), cvt_pk_bf16(att[8 * sp + 2], att[8 * sp + 3]), cvt_pk_bf16(att[8 * sp + 4], att[8 * sp + 5]), cvt_pk_bf16(att[8 * sp + 6], att[8 * sp + 7])};
            const char* vrow = vT + (32 * w + r) * 80 + (16 * sp + 4 * hq) * 2;
            const u32x2 lo = *(const u32x2*)vrow, hi = *(const u32x2*)(vrow + 16);
            o = mfma32<false>(pa, (u32x4){lo.x, lo.y, hi.x, hi.y}, o);
        }
#pragma unroll
        for (int db = 0; db < 4; ++db)
#pragma unroll
            for (int sp = 0; sp < 2; ++sp) {
                const int d0 = 32 * db + 16 * sp + 4 * hq;
                const u32x2 lo = *(const u32x2*)(qd + hg_off(r, d0)), hi = *(const u32x2*)(qd + hg_off(r, d0 + 8));
                const u32x4 sb = (u32x4){cvt_pk_bf16(S[db][8 * sp], S[db][8 * sp + 1]), cvt_pk_bf16(S[db][8 * sp + 2], S[db][8 * sp + 3]), cvt_pk_bf16(S[db][8 * sp + 4], S[db][8 * sp + 5]), cvt_pk_bf16(S[db][8 * sp + 6], S[db][8 * sp + 7])};
                o = mfma32<false>((u32x4){lo.x, lo.y, hi.x, hi.y}, sb, o);
            }
#pragma unroll
        for (int db = 0; db < 4; ++db) {
#pragma unroll
            for (int g4 = 0; g4 < 4; ++g4) {
                const f32x4 dc = *(const f32x4*)(decay + 32 * db + 8 * g4 + 4 * hq);
#pragma unroll
                for (int j = 0; j < 4; ++j) S[db][4 * g4 + j] *= dc[j];
            }
#pragma unroll
            for (int ks = 0; ks < 2; ++ks) {
                const u32x4 a = *(const u32x4*)(keT + (32 * db + r) * 80 + ks * 32 + hq * 16);
                const u32x4 b = *(const u32x4*)(vT + (32 * w + r) * 80 + ks * 32 + hq * 16);
                S[db] = mfma32<false>(a, b, S[db]);
            }
        }
#pragma unroll
        for (int e = 0; e < 16; ++e) {
            const int c = (e & 3) + 8 * (e >> 2) + 4 * hq;
            const int sidx = n * 32 + c;
            const int tok = tok0 + (dir ? T - 1 - sidx : sidx);
            od[(size_t)tok * 512 + head * 128 + 32 * w + r] = f2bf(o[e]);
        }
    }
    if (seq < 32) {
        float* so = p.out + OUT_STHG + ((size_t)(seq * 2 + dir) * 4 + head) * 16384;
#pragma unroll
        for (int db = 0; db < 4; ++db)
#pragma unroll
            for (int e = 0; e < 16; ++e) so[(size_t)(32 * db + (e & 3) + 8 * (e >> 2) + 4 * hq) * 128 + 32 * w + r] = S[db][e];
    }
}

__device__ __forceinline__ int rg_tok(int seq, int s) {
    if (seq < 32) return seq * 256 + s;
    const int col = s >> 4, row = s & 15;
    return NCTX_TOK + (seq - 32) * 1024 + row * 64 + col;
}
__device__ __forceinline__ void ph_rg_tiles(const P& p, int dirblk, int slot, int nslots, char* smem) {
    const int blk = dirblk & 7, dir = dirblk >> 3;
    const int t = tid_opaque(), lane = t & 63, w = t >> 6, r = lane & 31, hq = lane >> 5;
    const int ch = lane, sq = w, gch = blk * 64 + ch;
    char* WT = smem;
    char* XA = smem + 16384;
    float* G = (float*)(smem + 24576);
    float* car = (float*)(smem + 57344);
    const u16* xr = (const u16*)(p.ws + OFF_XR);
    u16* hlocp = (u16*)(p.ws + OFF_HF + (size_t)dir * 32 * MB); u16* acump = hlocp + (size_t)NTOK * 512;
    float* TT = (float*)(p.ws + OFF_TT);
    {
        const int n = t >> 1, kh = t & 1;
        const float* Wsrc = (n < 64 ? p.rg_wr : p.rg_wi) + ((size_t)(dir * 8 + blk) * 64) * 64 + (n & 63);
#pragma unroll
        for (int c4 = 0; c4 < 4; ++c4) {
            unsigned wv[4];
#pragma unroll
            for (int j = 0; j < 4; ++j) { const int k = kh * 32 + c4 * 8 + 2 * j; wv[j] = cvt_pk_bf16(Wsrc[(size_t)k * 64], Wsrc[(size_t)(k + 1) * 64]); }
            *(u32x4*)(WT + lds_off(n, kh * 4 + c4)) = (u32x4){wv[0], wv[1], wv[2], wv[3]};
        }
    }
    const float br = p.rg_br[dir * 512 + gch], bi = p.rg_bi[dir * 512 + gch];
    const float spl = softplusf_(-p.rg_lam[dir * 512 + gch]);
    const float cw0 = p.conv_w[0 * 512 + gch], cw1 = p.conv_w[1 * 512 + gch], cw2 = p.conv_w[2 * 512 + gch], cw3 = p.conv_w[3 * 512 + gch];
    const float cb = p.conv_b[gch];
    float win[19];
    auto load_win = [&](int ti_) {
        const int seq_ = ti_ < 128 ? (ti_ >> 2) : 32 + ((ti_ - 128) >> 4), j_ = ti_ < 128 ? (ti_ & 3) : ((ti_ - 128) & 15);
        const int T_ = seq_ < 32 ? 256 : 1024;
        const int s0_ = 64 * j_ + 16 * sq;
#pragma unroll
        for (int k = 0; k < 19; ++k) {
            const int pos = s0_ + k - 2;
            const bool ok = seq_ < 32 ? (pos >= 0 && pos < T_) : (k >= 2 && k < 18);
            const int posc = pos < 0 ? 0 : (pos >= T_ ? T_ - 1 : pos);
            const float v = bf2f(xr[(size_t)rg_tok(seq_, posc) * 512 + gch]);
            win[k] = ok ? v : 0.f;
        }
    };
    load_win(slot);
    for (int ti = slot; ti < 256; ti += nslots) {
        const int seq = ti < 128 ? (ti >> 2) : 32 + ((ti - 128) >> 4), j = ti < 128 ? (ti & 3) : ((ti - 128) & 15);
        const int s0 = 64 * j + 16 * sq;
        float xc[16];
#pragma unroll
        for (int i = 0; i < 16; ++i) {
            xc[i] = cb + cw0 * win[i] + cw1 * win[i + 1] + cw2 * win[i + 2] + cw3 * win[i + 3];
            *(u16*)(XA + lds_off(16 * sq + i, ch >> 3) + (ch & 7) * 2) = f2bf(xc[i]);
        }
        load_win(ti + nslots < 256 ? ti + nslots : ti);
        __syncthreads();
        {
            f32x16 acc[2];
#pragma unroll
            for (int mt = 0; mt < 2; ++mt)
#pragma unroll
                for (int e = 0; e < 16; ++e) acc[mt][e] = 0.f;
#pragma unroll
            for (int ks = 0; ks < 4; ++ks) {
                const u32x4 b = *(const u32x4*)(WT + lds_off(32 * w + r, 2 * ks + hq));
#pragma unroll
                for (int mt = 0; mt < 2; ++mt) {
                    const u32x4 a = *(const u32x4*)(XA + lds_off(32 * mt + r, 2 * ks + hq));
                    acc[mt] = mfma32<false>(a, b, acc[mt]);
                }
            }
#pragma unroll
            for (int mt = 0; mt < 2; ++mt)
#pragma unroll
                for (int e = 0; e < 16; ++e) G[(32 * mt + (e & 3) + 8 * (e >> 2) + 4 * hq) * 128 + 32 * w + r] = acc[mt][e];
        }
        __syncthreads();
        float av[16], uv[16];
#pragma unroll
        for (int i = 0; i < 16; ++i) {
            const float gr_ = G[(16 * sq + i) * 128 + ch] + br, gi_ = G[(16 * sq + i) * 128 + 64 + ch] + bi;
            const float rr = fsigmoid(gr_), ig = fsigmoid(gi_);
            const float log_a = -8.0f * rr * spl;
            const float a_ = __expf(log_a);
            av[i] = a_;
            uv[i] = __builtin_amdgcn_sqrtf(fmaxf(1.0f - a_ * a_, 0.f)) * (ig * xc[i]);
        }
        float Ap = 1.f, Hl = 0.f;
#pragma unroll
        for (int ii = 0; ii < 16; ++ii) { const int i = dir ? 15 - ii : ii; Hl = av[i] * Hl + uv[i]; Ap *= av[i]; }
        car[sq * 64 + ch] = Ap; car[256 + sq * 64 + ch] = Hl;
        __syncthreads();
        float h = 0.f, ac = 1.f;
#pragma unroll
        for (int qq = 0; qq < 3; ++qq) {
            const int qo = dir ? 3 - qq : qq;
            const bool before = dir ? (qo > sq) : (qo < sq);
            const float cA = car[qo * 64 + ch], cH = car[256 + qo * 64 + ch];
            h = before ? cA * h + cH : h; ac = before ? ac * cA : ac;
        }
#pragma unroll
        for (int ii = 0; ii < 16; ++ii) {
            const int i = dir ? 15 - ii : ii;
            h = av[i] * h + uv[i]; ac *= av[i];
            const size_t o = (size_t)rg_tok(seq, s0 + i) * 512 + gch;
            hlocp[o] = f2bf(h); acump[o] = f2bf(ac);
        }
        if (sq == (dir ? 0 : 3)) { TT[((size_t)(ti * 2 + dir) * 2 + 0) * 512 + gch] = ac; TT[((size_t)(ti * 2 + dir) * 2 + 1) * 512 + gch] = h; }
    }
    __syncthreads();
}

__device__ __forceinline__ void ph_rg_chain(const P& p, int seq, int dirblk, char* smem) {
    const int blk = dirblk & 7, dir = dirblk >> 3;
    const int t = tid_opaque(), lane = t & 63, w = t >> 6, r = lane & 31, hq = lane >> 5;
    const int ch = lane, sq = w, gch = blk * 64 + ch;
    char* WT = smem;
    char* XA = smem + 16384;
    float* G = (float*)(smem + 24576);
    float* car = (float*)(smem + 57344);
    float* tcar = (float*)(smem + 59392);
    const u16* xr = (const u16*)(p.ws + OFF_XR);
    u16* hlocp = (u16*)(p.ws + OFF_HF + (size_t)dir * 32 * MB);
    {
        const int n = t >> 1, kh = t & 1;
        const float* Wsrc = (n < 64 ? p.rg_wr : p.rg_wi) + ((size_t)(dir * 8 + blk) * 64) * 64 + (n & 63);
#pragma unroll
        for (int c4 = 0; c4 < 4; ++c4) {
            unsigned wv[4];
#pragma unroll
            for (int j = 0; j < 4; ++j) { const int k = kh * 32 + c4 * 8 + 2 * j; wv[j] = cvt_pk_bf16(Wsrc[(size_t)k * 64], Wsrc[(size_t)(k + 1) * 64]); }
            *(u32x4*)(WT + lds_off(n, kh * 4 + c4)) = (u32x4){wv[0], wv[1], wv[2], wv[3]};
        }
    }
    const float br = p.rg_br[dir * 512 + gch], bi = p.rg_bi[dir * 512 + gch];
    const float spl = softplusf_(-p.rg_lam[dir * 512 + gch]);
    const float cw0 = p.conv_w[0 * 512 + gch], cw1 = p.conv_w[1 * 512 + gch], cw2 = p.conv_w[2 * 512 + gch], cw3 = p.conv_w[3 * 512 + gch];
    const float cb = p.conv_b[gch];
    const int nt = seq < 32 ? 4 : 16, tib = seq < 32 ? seq * 4 : 128 + (seq - 32) * 16;
    const int T_ = seq < 32 ? 256 : 1024;
    if (w == 0) tcar[ch] = seq >= 32 ? p.state_rglru[(size_t)((seq - 32) * 2 + dir) * 512 + gch] : 0.f;
    float win[19];
    auto load_win = [&](int j_) {
        const int s0_ = 64 * j_ + 16 * sq;
#pragma unroll
        for (int k = 0; k < 19; ++k) {
            const int pos = s0_ + k - 2;
            const bool ok = seq < 32 ? (pos >= 0 && pos < T_) : (k >= 2 && k < 18);
            const int posc = pos < 0 ? 0 : (pos >= T_ ? T_ - 1 : pos);
            const float v = bf2f(xr[(size_t)rg_tok(seq, posc) * 512 + gch]);
            win[k] = ok ? v : 0.f;
        }
    };
    load_win(dir ? nt - 1 : 0);
    float hfin = 0.f;
    for (int jj = 0; jj < nt; ++jj) {
        const int j = dir ? nt - 1 - jj : jj;
        const int s0 = 64 * j + 16 * sq;
        float xc[16];
#pragma unroll
        for (int i = 0; i < 16; ++i) {
            xc[i] = cb + cw0 * win[i] + cw1 * win[i + 1] + cw2 * win[i + 2] + cw3 * win[i + 3];
            *(u16*)(XA + lds_off(16 * sq + i, ch >> 3) + (ch & 7) * 2) = f2bf(xc[i]);
        }
        { const int jn = jj + 1 < nt ? jj + 1 : jj; load_win(dir ? nt - 1 - jn : jn); }
        __syncthreads();
        {
            f32x16 acc[2];
#pragma unroll
            for (int mt = 0; mt < 2; ++mt)
#pragma unroll
                for (int e = 0; e < 16; ++e) acc[mt][e] = 0.f;
#pragma unroll
            for (int ks = 0; ks < 4; ++ks) {
                const u32x4 b = *(const u32x4*)(WT + lds_off(32 * w + r, 2 * ks + hq));
#pragma unroll
                for (int mt = 0; mt < 2; ++mt) {
                    const u32x4 a = *(const u32x4*)(XA + lds_off(32 * mt + r, 2 * ks + hq));
                    acc[mt] = mfma32<false>(a, b, acc[mt]);
                }
            }
#pragma unroll
            for (int mt = 0; mt < 2; ++mt)
#pragma unroll
                for (int e = 0; e < 16; ++e) G[(32 * mt + (e & 3) + 8 * (e >> 2) + 4 * hq) * 128 + 32 * w + r] = acc[mt][e];
        }
        __syncthreads();
        float av[16], uv[16];
#pragma unroll
        for (int i = 0; i < 16; ++i) {
            const float gr_ = G[(16 * sq + i) * 128 + ch] + br, gi_ = G[(16 * sq + i) * 128 + 64 + ch] + bi;
            const float rr = fsigmoid(gr_), ig = fsigmoid(gi_);
            const float log_a = -8.0f * rr * spl;
            const float a_ = __expf(log_a);
            av[i] = a_;
            uv[i] = __builtin_amdgcn_sqrtf(fmaxf(1.0f - a_ * a_, 0.f)) * (ig * xc[i]);
        }
        float Ap = 1.f, Hl = 0.f;
#pragma unroll
        for (int ii = 0; ii < 16; ++ii) { const int i = dir ? 15 - ii : ii; Hl = av[i] * Hl + uv[i]; Ap *= av[i]; }
        car[sq * 64 + ch] = Ap; car[256 + sq * 64 + ch] = Hl;
        __syncthreads();
        float h = tcar[(jj & 1) * 64 + ch];
#pragma unroll
        for (int qq = 0; qq < 3; ++qq) {
            const int qo = dir ? 3 - qq : qq;
            const bool before = dir ? (qo > sq) : (qo < sq);
            const float cA = car[qo * 64 + ch], cH = car[256 + qo * 64 + ch];
            h = before ? cA * h + cH : h;
        }
#pragma unroll
        for (int ii = 0; ii < 16; ++ii) {
            const int i = dir ? 15 - ii : ii;
            h = av[i] * h + uv[i];
            hlocp[(size_t)rg_tok(seq, s0 + i) * 512 + gch] = f2bf(h);
        }
        if (sq == (dir ? 0 : 3)) tcar[((jj + 1) & 1) * 64 + ch] = h;
        hfin = h;
    }
    if (seq < 32 && sq == (dir ? 0 : 3)) p.out[OUT_STRG + (size_t)(seq * 2 + dir) * 512 + gch] = hfin;
    __syncthreads();
}

__device__ __forceinline__ void ph_combine(const P& p, int item, char* smem) {
    const int tq = tid_opaque(); const int lane = tq & 63, wv = tq >> 6;
    const int ti = item >> 1, half = item & 1;
    const int seq = ti < 128 ? (ti >> 2) : 32 + ((ti - 128) >> 4), j = ti < 128 ? (ti & 3) : ((ti - 128) & 15);
    const int nt = seq < 32 ? 4 : 16, tib = ti - j;
    float* carF = (float*)smem; float* carB = carF + 512;
    const float* TT = (const float*)(p.ws + OFF_TT);
    const u16* HL = (const u16*)(p.ws + OFF_HF);
    auto load_pair = [&](int it, u32x4 (&ow)[2], u32x4 (&bw)[2], u32x4 (&sgv)[2], u32x4 (&grv)[2], u32x4 (&lf)[2], u32x4 (&af)[2], u32x4 (&lb)[2], u32x4 (&ab)[2]) {
#pragma unroll
        for (int u = 0; u < 2; ++u) {
            const int s = 64 * j + 32 * half + wv * 8 + it * 2 + u;
            const size_t o = (size_t)rg_tok(seq, s) * 512 + lane * 8;
            ow[u] = *(const u32x4*)((const u16*)p.out + o); bw[u] = *(const u32x4*)((const u16*)p.out + 8388608 + o);
            lf[u] = *(const u32x4*)(HL + o); af[u] = (u32x4){0u, 0u, 0u, 0u};
            lb[u] = *(const u32x4*)(HL + (size_t)32 * MB / 2 + o); ab[u] = (u32x4){0u, 0u, 0u, 0u};
            sgv[u] = *(const u32x4*)((const u16*)(p.ws + OFF_SG) + o); grv[u] = *(const u32x4*)((const u16*)(p.ws + OFF_GGR) + o);
        }
    };
    u32x4 Pow[2], Pbw[2], Psg[2], Pgr[2], Plf[2], Paf[2], Plb[2], Pab[2];
    u32x4 Qow[2], Qbw[2], Qsg[2], Qgr[2], Qlf[2], Qaf[2], Qlb[2], Qab[2];
    load_pair(0, Pow, Pbw, Psg, Pgr, Plf, Paf, Plb, Pab);
    const f32x4 ng0 = *(const f32x4*)(p.hgrn_norm_g + lane * 8), ng1 = *(const f32x4*)(p.hgrn_norm_g + lane * 8 + 4);
    const f32x4 cf0 = (f32x4){0.f, 0.f, 0.f, 0.f}, cf1 = cf0, cb0 = cf0, cb1 = cf0;
    auto compute_pair = [&](int it, const u32x4 (&ow)[2], const u32x4 (&bw)[2], const u32x4 (&sgv)[2], const u32x4 (&grv)[2], const u32x4 (&lf)[2], const u32x4 (&af)[2], const u32x4 (&lb)[2], const u32x4 (&ab)[2]) {
#pragma unroll
        for (int u = 0; u < 2; ++u) {
            const int tok = rg_tok(seq, 64 * j + 32 * half + wv * 8 + it * 2 + u);
            const u32x4 ofw = ow[u], obw = bw[u];
            const f32x4 o0 = (f32x4){__uint_as_float(ofw[0] << 16) + __uint_as_float(obw[0] << 16), __uint_as_float(ofw[0] & 0xFFFF0000u) + __uint_as_float(obw[0] & 0xFFFF0000u),
                                     __uint_as_float(ofw[1] << 16) + __uint_as_float(obw[1] << 16), __uint_as_float(ofw[1] & 0xFFFF0000u) + __uint_as_float(obw[1] & 0xFFFF0000u)};
            const f32x4 o1 = (f32x4){__uint_as_float(ofw[2] << 16) + __uint_as_float(obw[2] << 16), __uint_as_float(ofw[2] & 0xFFFF0000u) + __uint_as_float(obw[2] & 0xFFFF0000u),
                                     __uint_as_float(ofw[3] << 16) + __uint_as_float(obw[3] << 16), __uint_as_float(ofw[3] & 0xFFFF0000u) + __uint_as_float(obw[3] & 0xFFFF0000u)};
            float ss = (o0[0] * o0[0] + o0[1] * o0[1]) + (o0[2] * o0[2] + o0[3] * o0[3]) + (o1[0] * o1[0] + o1[1] * o1[1]) + (o1[2] * o1[2] + o1[3] * o1[3]);
            ss = sum16(ss);
            const float rs = rsqrtf(ss * (1.f / 128.f) + RMS_EPS);
            unsigned mw[4], yw[4];
#pragma unroll
            for (int jq = 0; jq < 4; ++jq) {
                const float m0 = (jq < 2 ? o0[2 * jq] : o1[2 * jq - 4]) * rs * (jq < 2 ? ng0[2 * jq] : ng1[2 * jq - 4]);
                const float m1 = (jq < 2 ? o0[2 * jq + 1] : o1[2 * jq - 3]) * rs * (jq < 2 ? ng0[2 * jq + 1] : ng1[2 * jq - 3]);
                const float cfa = jq < 2 ? cf0[2 * jq] : cf1[2 * jq - 4], cfb = jq < 2 ? cf0[2 * jq + 1] : cf1[2 * jq - 3];
                const float cba = jq < 2 ? cb0[2 * jq] : cb1[2 * jq - 4], cbb = jq < 2 ? cb0[2 * jq + 1] : cb1[2 * jq - 3];
                const unsigned l1 = lf[u][jq], c1 = af[u][jq], l2 = lb[u][jq], c2 = ab[u][jq];
                const float y0 = (__uint_as_float(l1 << 16) + __uint_as_float(c1 << 16) * cfa) + (__uint_as_float(l2 << 16) + __uint_as_float(c2 << 16) * cba);
                const float y1 = (__uint_as_float(l1 & 0xFFFF0000u) + __uint_as_float(c1 & 0xFFFF0000u) * cfb) + (__uint_as_float(l2 & 0xFFFF0000u) + __uint_as_float(c2 & 0xFFFF0000u) * cbb);
                const unsigned sgp = sgv[u][jq], grp = grv[u][jq];
                mw[jq] = cvt_pk_bf16(m0 * __uint_as_float(sgp << 16), m1 * __uint_as_float(sgp & 0xFFFF0000u));
                yw[jq] = cvt_pk_bf16(y0 * __uint_as_float(grp << 16), y1 * __uint_as_float(grp & 0xFFFF0000u));
            }
            u16* mix = (u16*)(p.ws + OFF_MIX) + (size_t)tok * DM + lane * 8;
            *(u32x4*)mix = (u32x4){mw[0], mw[1], mw[2], mw[3]};
            *(u32x4*)(mix + 512) = (u32x4){yw[0], yw[1], yw[2], yw[3]};
        }
    };
    load_pair(1, Qow, Qbw, Qsg, Qgr, Qlf, Qaf, Qlb, Qab);
    __builtin_amdgcn_sched_barrier(0);
    compute_pair(0, Pow, Pbw, Psg, Pgr, Plf, Paf, Plb, Pab);
    __builtin_amdgcn_sched_barrier(0);
    load_pair(2, Pow, Pbw, Psg, Pgr, Plf, Paf, Plb, Pab);
    __builtin_amdgcn_sched_barrier(0);
    compute_pair(1, Qow, Qbw, Qsg, Qgr, Qlf, Qaf, Qlb, Qab);
    __builtin_amdgcn_sched_barrier(0);
    load_pair(3, Qow, Qbw, Qsg, Qgr, Qlf, Qaf, Qlb, Qab);
    __builtin_amdgcn_sched_barrier(0);
    compute_pair(2, Pow, Pbw, Psg, Pgr, Plf, Paf, Plb, Pab);
    __builtin_amdgcn_sched_barrier(0);
    compute_pair(3, Qow, Qbw, Qsg, Qgr, Qlf, Qaf, Qlb, Qab);
    __syncthreads();
}

__device__ __forceinline__ void ln1_load(const P& p, int item, int tq, u32x4 (&xw)[4][2]) {
    const int tokb = item * 16 + (tq >> 6) * 4, lane = tq & 63;
#pragma unroll
    for (int u = 0; u < 4; ++u) {
        const u16* v = (const u16*)(p.ws + OFF_VBUF) + (size_t)(tokb + u) * DM + lane * 16;
        xw[u][0] = *(const u32x4*)v; xw[u][1] = *(const u32x4*)(v + 8);
    }
}
__device__ __forceinline__ void ph_ln1stats(const P& p, int item, int tq, const u32x4 (&xw)[4][2], const f32x4 (&lg)[4], const f32x4 (&lbb)[4]) {
    const int lane = tq & 63;
    const int tokb = item * 16 + (tq >> 6) * 4;
    f32x4 x[4][4];
#pragma unroll
    for (int u = 0; u < 4; ++u) { x[u][0] = h4_lo(xw[u][0]); x[u][1] = h4_hi(xw[u][0]); x[u][2] = h4_lo(xw[u][1]); x[u][3] = h4_hi(xw[u][1]); }
#pragma unroll
    for (int u = 0; u < 4; ++u) {
        const int tok = tokb + u;
        float s = 0.f;
#pragma unroll
        for (int c = 0; c < 4; ++c) s += (x[u][c][0] + x[u][c][1]) + (x[u][c][2] + x[u][c][3]);
        s = sum64(s);
        const float mu = s * (1.f / 1024.f); float q = 0.f;
#pragma unroll
        for (int c = 0; c < 4; ++c)
#pragma unroll
            for (int j = 0; j < 4; ++j) { const float d = x[u][c][j] - mu; q += d * d; }
        q = sum64(q);
        const float rstd = rsqrtf(q * (1.f / 1024.f) + LN_EPS);
        if (lane == 0) { float* st = (float*)(p.ws + OFF_STATS) + 2 * tok; st[0] = mu; st[1] = rstd; }
        const float* mod = (const float*)(p.ws + OFF_MOD) + cond_of_tok(tok) * 6144;
        unsigned hw[8];
#pragma unroll
        for (int c = 0; c < 4; ++c) {
            const int k = lane * 16 + c * 4;
            const f32x4 sc2 = *(const f32x4*)(mod + 4096 + k), sh2 = *(const f32x4*)(mod + 3072 + k);
            float h[4];
#pragma unroll
            for (int j = 0; j < 4; ++j) { const float x1 = (x[u][c][j] - mu) * rstd * lg[c][j] + lbb[c][j]; h[j] = x1 * (1.f + sc2[j]) + sh2[j]; }
            hw[2 * c] = cvt_pk_f16(h[0], h[1]); hw[2 * c + 1] = cvt_pk_f16(h[2], h[3]);
        }
        u16* h2 = (u16*)(p.ws + OFF_H2) + (size_t)tok * DM + lane * 16;
        *(u32x4*)h2 = (u32x4){hw[0], hw[1], hw[2], hw[3]}; *(u32x4*)(h2 + 8) = (u32x4){hw[4], hw[5], hw[6], hw[7]};
    }
}

__device__ __forceinline__ unsigned f2sort(float f) { const unsigned u = __float_as_uint(f); return u ^ ((unsigned)((int)u >> 31) | 0x80000000u); }
__device__ __forceinline__ float sort2f(unsigned k) { return __uint_as_float(k ^ (~(unsigned)((int)k >> 31) | 0x80000000u)); }
template <int N> __device__ __forceinline__ void bitonic_sort_desc(unsigned (&v)[N]) {
#pragma unroll
    for (int k = 2; k <= N; k <<= 1)
#pragma unroll
        for (int j = k >> 1; j > 0; j >>= 1)
#pragma unroll
            for (int i = 0; i < N; ++i) {
                const int l = i ^ j;
                if (l > i) {
                    const bool desc = ((i & k) == 0);
                    const unsigned a = v[i], b = v[l];
                    const unsigned mx = a > b ? a : b, mn = a > b ? b : a;
                    v[i] = desc ? mx : mn; v[l] = desc ? mn : mx;
                }
            }
}
__device__ __forceinline__ void sort16_desc(unsigned (&v)[16]) {
#define CE_(a, b) { const unsigned x_ = v[a], y_ = v[b]; v[a] = x_ > y_ ? x_ : y_; v[b] = x_ > y_ ? y_ : x_; }
    CE_(0,13) CE_(1,12) CE_(2,15) CE_(3,14) CE_(4,8) CE_(5,6) CE_(7,11) CE_(9,10)
    CE_(0,5) CE_(1,7) CE_(2,9) CE_(3,4) CE_(6,13) CE_(8,14) CE_(10,15) CE_(11,12)
    CE_(0,1) CE_(2,3) CE_(4,5) CE_(6,8) CE_(7,9) CE_(10,11) CE_(12,13) CE_(14,15)
    CE_(0,2) CE_(1,3) CE_(4,10) CE_(5,11) CE_(6,7) CE_(8,9) CE_(12,14) CE_(13,15)
    CE_(1,2) CE_(3,12) CE_(4,6) CE_(5,7) CE_(8,10) CE_(9,11) CE_(13,14)
    CE_(1,4) CE_(2,6) CE_(5,8) CE_(7,10) CE_(9,13) CE_(11,14)
    CE_(2,4) CE_(3,6) CE_(9,12) CE_(11,13)
    CE_(3,5) CE_(6,8) CE_(7,9) CE_(10,12)
    CE_(3,4) CE_(5,6) CE_(7,8) CE_(9,10) CE_(11,12)
    CE_(6,7) CE_(8,9)
#undef CE_
}
__device__ __forceinline__ void merge_top16(unsigned (&a)[16], const unsigned (&b)[16]) {
#pragma unroll
    for (int i = 0; i < 16; ++i) a[i] = a[i] > b[15 - i] ? a[i] : b[15 - i];
#pragma unroll
    for (int j = 8; j > 0; j >>= 1)
#pragma unroll
        for (int i = 0; i < 16; ++i) {
            const int l = i ^ j;
            if (l > i) { const unsigned x = a[i], y = a[l]; a[i] = x > y ? x : y; a[l] = x > y ? y : x; }
        }
}
struct CandTab { unsigned char v[64]; };
__host__ __device__ constexpr CandTab make_ctab() {
    CandTab t{}; int n = 0;
    for (int f = 0; f < 256; ++f) { const int i = f >> 4, j = f & 15; if ((i + 1) * (j + 1) <= 16) t.v[n++] = (unsigned char)f; }
    for (; n < 64; ++n) t.v[n] = 255;
    return t;
}
__device__ const CandTab g_ctab = make_ctab();

__device__ __forceinline__ void ph_topk_load_keys(const P& p, int head, char* smem) {
    const int t = tid_opaque();
    const u16* ksrc = (const u16*)(p.ws + OFF_KEYS16) + (size_t)head * 2 * 128 * 128;
#pragma unroll
    for (int i = 0; i < 16; ++i) {
        const int cidx = t + 256 * i, row = cidx >> 4, ch = cidx & 15;
        *(u32x4*)(smem + row * 256 + ((ch ^ (row & 15)) << 4)) = *(const u32x4*)(ksrc + row * 128 + ch * 8);
    }
}
__device__ __forceinline__ void ph_topk(const P& p, int item, int next_item, u32x4 (&qf)[8], char* smem) {
    const int tile = item >> 3, head = item & 7;
    const int t = tid_opaque(), lane = t & 63, wid = t >> 6, tt = wid & 1, pp = wid >> 1, r = lane & 31, hq = lane >> 5;
    unsigned* topk = (unsigned*)(smem + 65536);
    unsigned char* ctab = (unsigned char*)(smem + 65536 + 8192);
    if (t < 64) ctab[t] = g_ctab.v[t];
    const int tok0 = tile * 64;
    {
        unsigned srt[4][16];
#pragma unroll
        for (int kb = 0; kb < 4; ++kb) {
            u32x4 kf[8];
#pragma unroll
            for (int ks = 0; ks < 8; ++ks) kf[ks] = *(const u32x4*)(smem + (pp * 128 + kb * 32 + r) * 256 + (((2 * ks + hq) ^ (r & 15)) << 4));
            f32x16 acc, acc1;
#pragma unroll
            for (int e = 0; e < 16; ++e) { acc[e] = 0.f; acc1[e] = 0.f; }
#pragma unroll
            for (int ks = 0; ks < 8; ks += 2) { acc = mfma32<true>(kf[ks], qf[ks], acc); acc1 = mfma32<true>(kf[ks + 1], qf[ks + 1], acc1); }
#pragma unroll
            for (int e = 0; e < 16; ++e) acc[e] += acc1[e];
#pragma unroll
            for (int e = 0; e < 16; ++e) {
                const int kidx = kb * 32 + (e & 3) + 8 * (e >> 2);
                srt[kb][e] = (f2sort(acc[e]) & ~127u) | (unsigned)(127 - kidx - 4 * hq);
            }
            sort16_desc(srt[kb]);
        }
        {
            const u16* qrow = (const u16*)p.out + (size_t)((next_item >> 3) * 64 + tt * 32 + r) * 2048 + head * 256 + pp * 128 + hq * 8;
#pragma unroll
            for (int ks = 0; ks < 8; ++ks) qf[ks] = *(const u32x4*)(qrow + ks * 16);
        }
        merge_top16(srt[0], srt[1]); merge_top16(srt[2], srt[3]); merge_top16(srt[0], srt[2]);
        unsigned oth[16];
#pragma unroll
        for (int i = 0; i < 16; ++i) oth[i] = (unsigned)__shfl_xor((int)srt[0][i], 32);
        merge_top16(srt[0], oth);
        if (hq == 0) {
            u32x4* d = (u32x4*)(topk + ((tt * 32 + r) * 2 + pp) * 16);
#pragma unroll
            for (int i = 0; i < 4; ++i) d[i] = (u32x4){srt[0][4 * i], srt[0][4 * i + 1], srt[0][4 * i + 2], srt[0][4 * i + 3]};
        }
    }
    __syncthreads();
    {
        const int m = wid * 16 + (lane >> 2), sub = lane & 3;
        const unsigned* tk0 = topk + (m * 2 + 0) * 16; const unsigned* tk1 = tk0 + 16;
        unsigned cd[16];
#pragma unroll
        for (int n = 0; n < 16; ++n) {
            const int pos = sub * 16 + n;
            const unsigned f = ctab[pos];
            const unsigned k0 = tk0[(f >> 4) & 15], k1 = tk1[f & 15];
            const float cv = sort2f(k0 & ~127u) + sort2f(k1 & ~127u);
            cd[n] = (f == 255u) ? 0u : ((f2sort(cv) & ~63u) | (unsigned)(63 - pos));
        }
        sort16_desc(cd);
        unsigned oth[16];
#pragma unroll
        for (int i = 0; i < 16; ++i) oth[i] = (unsigned)__shfl_xor((int)cd[i], 1);
        merge_top16(cd, oth);
#pragma unroll
        for (int i = 0; i < 16; ++i) oth[i] = (unsigned)__shfl_xor((int)cd[i], 2);
        merge_top16(cd, oth);
        float ex[16]; float sum = 0.f;
        const float f0 = sort2f(cd[0] & ~63u);
#pragma unroll
        for (int i = 0; i < 16; ++i) { ex[i] = __expf(sort2f(cd[i] & ~63u) - f0); sum += ex[i]; }
        const float inv = 1.0f / sum;
        unsigned* pick_out = (unsigned*)(p.ws + OFF_IDX) + (size_t)(tok0 + m) * 128 + head * 16 + sub * 4;
        int eo[4]; float go[4];
#pragma unroll
        for (int i = 0; i < 4; ++i) {
            const unsigned kk = sub == 0 ? cd[i] : sub == 1 ? cd[4 + i] : sub == 2 ? cd[8 + i] : cd[12 + i];
            const float ee = sub == 0 ? ex[i] : sub == 1 ? ex[4 + i] : sub == 2 ? ex[8 + i] : ex[12 + i];
            const unsigned f = ctab[63 - (kk & 63u)];
            const unsigned k0 = tk0[(f >> 4) & 15], k1 = tk1[f & 15];
            eo[i] = (int)((127u - (k0 & 127u)) * 128u + (127u - (k1 & 127u)));
            go[i] = ee * inv;
        }
        unsigned pkv[4];
#pragma unroll
        for (int i = 0; i < 4; ++i) { unsigned gq = (unsigned)(go[i] * 262144.0f + 0.5f); gq = gq > 262143u ? 262143u : gq; pkv[i] = ((unsigned)eo[i] << 18) | gq; }
        *(u32x4*)pick_out = (u32x4){pkv[0], pkv[1], pkv[2], pkv[3]};
    }
    __syncthreads();
}

typedef unsigned v6u32 __attribute__((ext_vector_type(6)));
typedef _Float16 v32h __attribute__((ext_vector_type(32)));
typedef float v32f __attribute__((ext_vector_type(32)));
__device__ __forceinline__ void ph_cvt_tables(const P& p, int gwave, int nwaves, char* smem, int row_lo = 0, int row_hi = 2 * 16384) {
    const int tq = tid_opaque(), lane = tq & 63, rsub = lane >> 5, gi = lane & 31, q = gi >> 1, half = gi & 1;
    float* SC = (float*)(p.ws + OFF_TSC);
    float* tl = (float*)(smem + (tq >> 6) * 18432);
    f32x4 xn[4][4];
    auto cv_load = [&](int row0_) {
#pragma unroll
        for (int rr = 0; rr < 4; ++rr) {
            const int row = row0_ + rr;
            const float* src = (row < 16384 ? p.peer_u + (size_t)row * DM : p.peer_v + (size_t)(row - 16384) * DM) + lane * 4;
#pragma unroll
            for (int i = 0; i < 4; ++i) xn[rr][i] = __builtin_nontemporal_load((const f32x4*)(src + i * 256));
        }
    };
    cv_load(row_lo + gwave * 4 < row_hi ? row_lo + gwave * 4 : 0);
#pragma unroll 1
    for (int row0 = row_lo + gwave * 4; row0 < row_hi; row0 += nwaves * 4) {
        f32x4 x[4][4];
#pragma unroll
        for (int rr = 0; rr < 4; ++rr)
#pragma unroll
            for (int i = 0; i < 4; ++i) x[rr][i] = xn[rr][i];
        cv_load(row0 + nwaves * 4 < row_hi ? row0 + nwaves * 4 : row0);
#pragma unroll
        for (int rr = 0; rr < 4; ++rr)
#pragma unroll
            for (int i = 0; i < 4; ++i) *(f32x4*)(tl + rr * 1152 + (8 * i + (lane >> 3)) * 36 + 4 * (lane & 7)) = x[rr][i];
#pragma unroll
        for (int pr = 0; pr < 2; ++pr) {
            const int row = row0 + pr * 2 + rsub;
            f32x4 y[8];
#pragma unroll
            for (int i = 0; i < 8; ++i) y[i] = *(const f32x4*)(tl + (pr * 2 + rsub) * 1152 + gi * 36 + i * 4);
            float am = 0.f;
#pragma unroll
            for (int i = 0; i < 8; ++i) am = fmaxf(am, fmaxf(fmaxf(fabsf(y[i][0]), fabsf(y[i][1])), fmaxf(fabsf(y[i][2]), fabsf(y[i][3]))));
            am = fmaxf(am, dpp_f<0xB1>(am));
            if (row0 < 16384) {
                const float inv = am > 0.f ? 7.0f / am : 1.0f;
                unsigned pk[4];
#pragma unroll
                for (int d = 0; d < 4; ++d) {
                    unsigned o = 0u;
#pragma unroll
                    for (int e = 7; e >= 0; --e) {
                        const int qv = (int)__builtin_rintf(y[2 * d + (e >> 2)][e & 3] * inv);
                        o = (o << 4) | ((unsigned)qv & 15u);
                    }
                    pk[d] = o;
                }
                char* dst = p.ws + OFF_U8 + (size_t)row * 576;
                *(u32x4*)(dst + half * 256 + q * 16) = (u32x4){pk[0], pk[1], pk[2], pk[3]};
                if (half == 0) *(float*)(dst + 512 + q * 4) = am > 0.f ? am * (1.0f / 7.0f) : 1.0f;
            } else {
                am = fmaxf(am, dpp_f<0x4E>(am)); am = fmaxf(am, dpp_f<0x141>(am)); am = fmaxf(am, dpp_f<0x140>(am));
                am = fmaxf(am, __shfl_xor(am, 16));
                const float inv = am > 0.f ? 6.0f / am : 1.0f;
                unsigned pk[4];
#pragma unroll
                for (int d = 0; d < 4; ++d) {
                    unsigned o = 0u;
                    o = __builtin_amdgcn_cvt_scalef32_pk_fp4_f32(o, y[2 * d][0] * inv, y[2 * d][1] * inv, 1.0f, 0);
                    o = __builtin_amdgcn_cvt_scalef32_pk_fp4_f32(o, y[2 * d][2] * inv, y[2 * d][3] * inv, 1.0f, 1);
                    o = __builtin_amdgcn_cvt_scalef32_pk_fp4_f32(o, y[2 * d + 1][0] * inv, y[2 * d + 1][1] * inv, 1.0f, 2);
                    o = __builtin_amdgcn_cvt_scalef32_pk_fp4_f32(o, y[2 * d + 1][2] * inv, y[2 * d + 1][3] * inv, 1.0f, 3);
                    pk[d] = o;
                }
                *(u32x4*)(p.ws + OFF_V8 + (size_t)(row - 16384) * 512 + half * 256 + q * 16) = (u32x4){pk[0], pk[1], pk[2], pk[3]};
                if (gi == 0) SC[row] = am > 0.f ? am * (1.0f / 6.0f) : 1.0f;
            }
        }
    }
}

typedef _Float16 h16x2 __attribute__((ext_vector_type(2)));
__device__ __forceinline__ h16x2 ash2(unsigned u) { return __builtin_bit_cast(h16x2, u); }

__device__ __forceinline__ unsigned umed3(unsigned a, unsigned b, unsigned c) {
    const unsigned mn = a < b ? a : b, mx = a < b ? b : a; const unsigned t = mx < c ? mx : c; return mn > t ? mn : t; }
__device__ __forceinline__ void sort128_group(unsigned (&key)[8], int q) {
#pragma unroll
    for (int k = 2; k <= 128; k <<= 1)
#pragma unroll
        for (int j = k >> 1; j > 0; j >>= 1) {
            if (j < 8) {
                if (k < 8) {
#pragma unroll
                    for (int r = 0; r < 8; ++r) {
                        const int r2 = r ^ j;
                        if (r2 > r) {
                            const bool asc = (r & k) == 0;
                            const unsigned a = key[r], b = key[r2];
                            const unsigned lo = a < b ? a : b, hi = a < b ? b : a;
                            key[r] = asc ? lo : hi; key[r2] = asc ? hi : lo;
                        }
                    }
                } else {
                    const unsigned bl = (((q << 3) & k) == 0) ? 0u : ~0u, bh = ~bl;
#pragma unroll
                    for (int r = 0; r < 8; ++r) {
                        const int r2 = r ^ j;
                        if (r2 > r) { const unsigned a = key[r], b = key[r2]; key[r] = umed3(a, b, bl); key[r2] = umed3(a, b, bh); }
                    }
                }
            } else {
                const int m = j >> 3;
                const bool lower = (q & m) == 0, asc = ((q << 3) & k) == 0;
                const unsigned bnd = (lower == asc) ? 0u : ~0u;
#pragma unroll
                for (int r = 0; r < 8; ++r) {
                    const unsigned o = (unsigned)__shfl_xor((int)key[r], m);
                    key[r] = umed3(key[r], o, bnd);
                }
            }
        }
}
__device__ __forceinline__ void ph_peer_out(const P& p, int item, char* smem) {
    const int tq = tid_opaque(); const int lane = tq & 63, g = lane >> 4, q = lane & 15;
    const int tok = item * 16 + (tq >> 6) * 4 + g;
    const unsigned char* U8 = (const unsigned char*)(p.ws + OFF_U8); const unsigned char* V8 = (const unsigned char*)(p.ws + OFF_V8);
    const float* SV = (const float*)(p.ws + OFF_TSC) + 16384;
    const u16* H2 = (const u16*)(p.ws + OFF_H2) + (size_t)tok * DM;
    unsigned hd[2][8];
    float hs;
    {
        u32x4 hh[8];
#pragma unroll
        for (int i = 0; i < 8; ++i) hh[i] = *(const u32x4*)(H2 + q * 64 + i * 8);
        float hv[64];
#pragma unroll
        for (int i = 0; i < 8; ++i)
#pragma unroll
            for (int jj = 0; jj < 4; ++jj) { const unsigned wv_ = hh[i][jj]; const h16x2 pr_ = ash2(wv_); hv[8 * i + 2 * jj] = (float)pr_[0]; hv[8 * i + 2 * jj + 1] = (float)pr_[1]; }
        float hm = 0.f;
#pragma unroll
        for (int e = 0; e < 64; ++e) hm = fmaxf(hm, fabsf(hv[e]));
        hm = fmaxf(hm, dpp_f<0xB1>(hm)); hm = fmaxf(hm, dpp_f<0x4E>(hm)); hm = fmaxf(hm, dpp_f<0x141>(hm)); hm = fmaxf(hm, dpp_f<0x140>(hm));
        const float hinv = hm > 0.f ? 119.0f / hm : 1.0f;
        hs = hm > 0.f ? hm * (1.0f / 119.0f) : 1.0f;
#pragma unroll
        for (int d = 0; d < 8; ++d) {
            unsigned o0 = 0u, o1 = 0u;
#pragma unroll
            for (int e = 7; e >= 0; --e) {
                const int qv = (int)__builtin_rintf(hv[8 * d + e] * hinv);
                const int q1 = (qv + 8) >> 4;
                o0 = (o0 << 4) | ((unsigned)qv & 15u); o1 = (o1 << 4) | ((unsigned)q1 & 15u);
            }
            hd[0][d] = o0; hd[1][d] = o1;
        }
    }
    unsigned key[8];
    {
        const unsigned* pk = (const unsigned*)(p.ws + OFF_IDX) + (size_t)tok * 128 + q * 8;
        const u32x4 ka = *(const u32x4*)pk, kb = *(const u32x4*)(pk + 4);
        key[0] = ka[0]; key[1] = ka[1]; key[2] = ka[2]; key[3] = ka[3]; key[4] = kb[0]; key[5] = kb[1]; key[6] = kb[2]; key[7] = kb[3];
    }
    sort128_group(key, q);
    unsigned* kl = (unsigned*)(smem + (tq >> 6) * 16384) + g * 128;
    *(u32x4*)(kl + q * 8) = (u32x4){key[0], key[1], key[2], key[3]}; *(u32x4*)(kl + q * 8 + 4) = (u32x4){key[4], key[5], key[6], key[7]};
    u32x4 ub[8][2]; float us[8];
#pragma unroll
    for (int b = 0; b < 8; ++b) {
        const unsigned char* r0 = U8 + (size_t)(kl[b] >> 18) * 576 + q * 16;
        ub[b][0] = *(const u32x4*)r0; ub[b][1] = *(const u32x4*)(r0 + 256); us[b] = *(const float*)(r0 + 512 - q * 12);
    }
    {
        float* svl = (float*)(kl + 1536);
        float b[8];
#pragma unroll
        for (int r = 0; r < 8; ++r) { const int e = (int)(key[r] >> 18); b[r] = SV[e]; }
        *(f32x4*)(svl + q * 8) = (f32x4){b[0], b[1], b[2], b[3]}; *(f32x4*)(svl + q * 8 + 4) = (f32x4){b[4], b[5], b[6], b[7]};
    }
    float* wl = (float*)(kl + 512);
    {
        const bool s3 = (q & 8) != 0, s2 = (q & 4) != 0, s1 = (q & 2) != 0;
#pragma unroll 1
        for (int j = 0; j < 128; j += 8) {
            float part[8];
#pragma unroll
            for (int b = 0; b < 8; ++b) {
                u32x4 rw0 = ub[b][0], rw1 = ub[b][1];
                asm volatile("" : "+v"(rw0), "+v"(rw1));
                int D0 = 0, D1 = 0;
#pragma unroll
                for (int d = 0; d < 8; ++d) {
                    const int uw = (int)(d < 4 ? rw0[d & 3] : rw1[d & 3]);
                    D0 = __builtin_amdgcn_sdot8(uw, (int)hd[0][d], D0, false);
                    D1 = __builtin_amdgcn_sdot8(uw, (int)hd[1][d], D1, false);
                }
                part[b] = (float)(D0 + (D1 << 4)) * us[b];
                const int jn = j + b + 8 < 128 ? j + b + 8 : 127;
                const unsigned char* rn = U8 + (size_t)(kl[jn] >> 18) * 576 + q * 16;
                ub[b][0] = *(const u32x4*)rn; ub[b][1] = *(const u32x4*)(rn + 256); us[b] = *(const float*)(rn + 512 - q * 12);
            }
            float r4[4], r2[2];
#pragma unroll
            for (int i = 0; i < 4; ++i) { const float keep = s3 ? part[i + 4] : part[i], send = s3 ? part[i] : part[i + 4]; r4[i] = keep + dpp_f<0x140>(send); }
#pragma unroll
            for (int i = 0; i < 2; ++i) { const float keep = s2 ? r4[i + 2] : r4[i], send = s2 ? r4[i] : r4[i + 2]; r2[i] = keep + dpp_f<0x141>(send); }
            float r1;
            { const float keep = s1 ? r2[1] : r2[0], send = s1 ? r2[0] : r2[1]; r1 = keep + dpp_f<0x4E>(send); }
            r1 += dpp_f<0xB1>(r1);
            const int m = q >> 1;
            const unsigned k0 = kl[j + m];
            const float sv0 = ((const float*)(kl + 1536))[j + m];
            const float d0 = r1 * hs;
            const float w0 = (float)(k0 & 0x3FFFFu) * (1.0f / 262144.0f) * fgelu(d0) * sv0;
            if ((q & 1) == 0) wl[j + m] = w0;
        }
    }
    const int tokw = item * 16 + (tq >> 6) * 4;
    const int k0 = lane * 16;
    u32x4 vw[4][2];
#pragma unroll
    for (int tk = 0; tk < 4; ++tk) {
        const u16* vb = (const u16*)(p.ws + OFF_VBUF) + (size_t)(tokw + tk) * DM + k0;
        vw[tk][0] = *(const u32x4*)vb; vw[tk][1] = *(const u32x4*)(vb + 8);
    }
    float ff[64];
#pragma unroll
    for (int e = 0; e < 64; ++e) ff[e] = 0.f;
    asm volatile("" ::: "memory");
    {
        u32x4 vb8[8][2];
#pragma unroll
        for (int b = 0; b < 8; ++b) {
            const unsigned char* r0 = V8 + (size_t)(kl[b] >> 18) * 512 + q * 16;
            vb8[b][0] = *(const u32x4*)r0; vb8[b][1] = *(const u32x4*)(r0 + 256);
        }
#pragma unroll 1
        for (int j = 0; j < 128; j += 8) {
#pragma unroll
            for (int b = 0; b < 8; ++b) {
                const float w = wl[j + b];
                const f32x2 w2 = (f32x2){w, w};
                u32x4 rw0 = vb8[b][0], rw1 = vb8[b][1];
                asm volatile("" : "+v"(rw0), "+v"(rw1));
#pragma unroll
                for (int d = 0; d < 8; ++d) {
                    const unsigned dw = d < 4 ? rw0[d & 3] : rw1[d & 3];
                    const f32x2 v0 = __builtin_amdgcn_cvt_scalef32_pk_f32_fp4(dw, 1.0f, 0), v1 = __builtin_amdgcn_cvt_scalef32_pk_f32_fp4(dw, 1.0f, 1);
                    const f32x2 v2 = __builtin_amdgcn_cvt_scalef32_pk_f32_fp4(dw, 1.0f, 2), v3 = __builtin_amdgcn_cvt_scalef32_pk_f32_fp4(dw, 1.0f, 3);
                    ff[8 * d + 0] += w2[0] * v0[0]; ff[8 * d + 1] += w2[1] * v0[1]; ff[8 * d + 2] += w2[0] * v1[0]; ff[8 * d + 3] += w2[1] * v1[1];
                    ff[8 * d + 4] += w2[0] * v2[0]; ff[8 * d + 5] += w2[1] * v2[1]; ff[8 * d + 6] += w2[0] * v3[0]; ff[8 * d + 7] += w2[1] * v3[1];
                }
                const int jn = j + b + 8 < 128 ? j + b + 8 : 127;
                const unsigned char* rn = V8 + (size_t)(kl[jn] >> 18) * 512 + q * 16;
                vb8[b][0] = *(const u32x4*)rn; vb8[b][1] = *(const u32x4*)(rn + 256);
            }
        }
    }
    float* fl = (float*)(smem + (tq >> 6) * 16384);
#pragma unroll
    for (int c = 0; c < 16; ++c) *(f32x4*)(fl + g * 1024 + q * 64 + c * 4) = (f32x4){ff[c * 4], ff[c * 4 + 1], ff[c * 4 + 2], ff[c * 4 + 3]};
    const float* mod = (const float*)(p.ws + OFF_MOD) + cond_of_tok(tokw) * 6144;
    f32x4 l1g[4], l1b[4], g2[4], l2g[4], l2b[4]; float mu1[4], rs1[4];
#pragma unroll
    for (int tk = 0; tk < 4; ++tk) { const float* st = (const float*)(p.ws + OFF_STATS) + 2 * (tokw + tk); mu1[tk] = st[0]; rs1[tk] = st[1]; }
#pragma unroll
    for (int c = 0; c < 4; ++c) {
        const int k = k0 + c * 4;
        l1g[c] = *(const f32x4*)(p.ln1_g + k); l1b[c] = *(const f32x4*)(p.ln1_b + k); g2[c] = *(const f32x4*)(mod + 5120 + k);
        l2g[c] = *(const f32x4*)(p.ln2_g + k); l2b[c] = *(const f32x4*)(p.ln2_b + k);
    }
#pragma unroll
    for (int tk = 0; tk < 4; ++tk) {
        float y[16]; float s = 0.f;
        const f32x4 vv4[4] = {h4_lo(vw[tk][0]), h4_hi(vw[tk][0]), h4_lo(vw[tk][1]), h4_hi(vw[tk][1])};
#pragma unroll
        for (int c = 0; c < 4; ++c) {
            const f32x4 fv = *(const f32x4*)(fl + tk * 1024 + k0 + c * 4);
#pragma unroll
            for (int j = 0; j < 4; ++j) { const float x1 = (vv4[c][j] - mu1[tk]) * rs1[tk] * l1g[c][j] + l1b[c][j]; const float yy = ALPHA_C * x1 + g2[c][j] * fv[j]; y[c * 4 + j] = yy; s += yy; }
        }
        s = sum64(s);
        const float mu = s * (1.f / 1024.f); float qq = 0.f;
#pragma unroll
        for (int e = 0; e < 16; ++e) { const float d = y[e] - mu; qq += d * d; }
        qq = sum64(qq);
        const float rstd = rsqrtf(qq * (1.f / 1024.f) + LN_EPS);
        float* o = p.out + (size_t)(tokw + tk) * DM + k0;
#pragma unroll
        for (int c = 0; c < 4; ++c) {
            f32x4 rr;
#pragma unroll
            for (int j = 0; j < 4; ++j) rr[j] = (y[c * 4 + j] - mu) * rstd * l2g[c][j] + l2b[c][j];
            *(f32x4*)(o + c * 4) = rr;
        }
    }
}

constexpr int SMEM_BYTES = 65536 + 8192 + 256 + 16;
__global__ void __launch_bounds__(256, 2) mega(P p) {
    __shared__ __attribute__((aligned(16))) char smem[SMEM_BYTES];
    const int nb = gridDim.x, bid = blockIdx.x;
    if (threadIdx.x == 0) *(uint4*)(smem + SMEM_BYTES - 16) = make_uint4(0u, 0u, 0u, 0u);
    __syncthreads();
    const XcdBarrier xb = xcd_barrier_post((unsigned*)(p.ws + OFF_BAR), (volatile LAS unsigned*)(smem + SMEM_BYTES - 16));
    constexpr size_t OFF_HWKEY = 832 << 10;
    if (threadIdx.x == 0) ((unsigned*)(p.ws + OFF_HWKEY))[bid] = (xb.x << 8) | (((unsigned)__builtin_amdgcn_s_getreg(63492) >> 8) & 0xFFu);
    constexpr int NIT = 384 + 896 + 256 + 512;
    auto tr_loop = [&](int it, const int itEnd, const int stride) {
        const int t = tid_opaque();
        float (*tile)[65] = (float (*)[65])smem;
        auto tr_load = [&](int i_, f32x4 (&v)[4]) {
            const float* src; int N, item;
            if (i_ < 384 + 896) { src = p.w_in; N = DIN; item = i_ - 384; }
            else if (i_ < 384 + 896 + 256) { src = p.w_out; N = DM; item = i_ - 384 - 896; }
            else { src = p.peer_wq; N = 2048; item = i_ - 384 - 896 - 256; }
            const int ntn = N >> 6, kt = item / ntn, nt = item - kt * ntn;
#pragma unroll
            for (int i = 0; i < 4; ++i) v[i] = *(const f32x4*)(src + (size_t)(kt * 64 + (t >> 4) + 16 * i) * N + nt * 64 + (t & 15) * 4);
        };
        f32x4 v[4];
        tr_load(it < itEnd ? it : itEnd - 1, v);
#pragma unroll 1
        for (; it < itEnd; it += stride) {
#pragma unroll
            for (int i = 0; i < 4; ++i) { const int k = (t >> 4) + 16 * i, n4 = (t & 15) * 4; tile[k][n4] = v[i][0]; tile[k][n4 + 1] = v[i][1]; tile[k][n4 + 2] = v[i][2]; tile[k][n4 + 3] = v[i][3]; }
            __syncthreads();
            tr_load(it + stride < itEnd ? it + stride : it, v);
            u16* dst; int N, item; bool f16;
            if (it < 384 + 896) { dst = (u16*)(p.ws + OFF_WIN_T); N = DIN; item = it - 384; f16 = false; }
            else if (it < 384 + 896 + 256) { dst = (u16*)(p.ws + OFF_WOUT_T); N = DM; item = it - 384 - 896; f16 = false; }
            else { dst = (u16*)(p.ws + OFF_WQ_T); N = 2048; item = it - 384 - 896 - 256; f16 = true; }
            const int ntn = N >> 6, kt = item / ntn, nt = item - kt * ntn;
            const int n = t >> 2, kq = (t & 3) * 16;
            unsigned w[8];
#pragma unroll
            for (int j = 0; j < 8; ++j) {
                const float a = tile[kq + 2 * j][n], b = tile[kq + 2 * j + 1][n];
                w[j] = f16 ? cvt_pk_f16(a, b) : cvt_pk_bf16(a, b);
            }
            u16* d = dst + (size_t)(nt * 64 + n) * DM + kt * 64 + kq;
            *(u32x4*)d = (u32x4){w[0], w[1], w[2], w[3]}; *(u32x4*)(d + 8) = (u32x4){w[4], w[5], w[6], w[7]};
            __syncthreads();
        }
    };
    const bool p512 = nb == 512;
    const int nidle = nb > 384 ? nb - 384 : 0;
    const int NA = p512 ? 896 : (4 * nidle < NIT - 384 ? 4 * nidle : NIT - 384);
    for (int it = bid; it < 384; it += nb) ph_mod1(p, it, smem);
    if (p512) { if (bid < 384) tr_loop(896 + bid, 1280, nb); else tr_loop(384 + (bid - 384), 896, 128); }
    else if (bid >= 384) tr_loop(384 + (bid - 384), 384 + NA, nidle);
    for (int c = bid * 256 + threadIdx.x; c < 8 * 2 * 128 * 128 / 8; c += nb * 256) {
        const f32x4 a = *(const f32x4*)(p.peer_keys + (size_t)c * 8), b = *(const f32x4*)(p.peer_keys + (size_t)c * 8 + 4);
        ((u32x4*)(p.ws + OFF_KEYS16))[c] = (u32x4){cvt_pk_f16(a[0], a[1]), cvt_pk_f16(a[2], a[3]), cvt_pk_f16(b[0], b[1]), cvt_pk_f16(b[2], b[3])};
    }
    xcd_barrier(xb);
    int vb = bid; bool even_xcc = false;
    if ((nb & 7) == 0) {
        const unsigned* hk = (const unsigned*)(p.ws + OFF_HWKEY);
        const unsigned mykey = hk[bid];
        int cnt = 0;
        for (int b = threadIdx.x; b < nb; b += 256) { const unsigned kb_ = hk[b]; cnt += (kb_ < mykey || (kb_ == mykey && b < bid)) ? 1 : 0; }
        int* racc = (int*)smem;
        if (threadIdx.x < 17) racc[threadIdx.x] = 0;
        __syncthreads();
        if (cnt) atomicAdd(racc, cnt);
        for (int b = threadIdx.x; b < nb; b += 256) atomicAdd(racc + 1 + ((hk[b] >> 8) & 15u), 1);
        __syncthreads();
        const int rank = *racc, per = nb >> 3;
        bool ev = true;
#pragma unroll
        for (int j = 0; j < 16; ++j) { const int c = racc[1 + j]; ev = ev && (c == 0 || c == per); }
        __syncthreads();
        vb = (rank % per) * 8 + rank / per;
        even_xcc = ev;
    }
    const bool grp = nb == 512 && even_xcc;
    const int gg = vb & 7, gk = vb >> 3;
    ph_mod2(p, bid * 256 + threadIdx.x, nb * 256);
    if (grp) ph_make_h(p, 64 * gg + gk, smem);
    else for (int g = bid; g < NTOK / 32; g += nb) ph_make_h(p, g, smem);
    if (!p512) tr_loop(384 + NA + bid, NIT, nb);
    if (grp) xcd_local_barrier(xb); else xcd_barrier(xb);
    gemm_phase<false, EPI1, 1>(p, (const u16*)(p.ws + OFF_HIN), DM, (const u16*)(p.ws + OFF_WIN_T), DM, 28, vb, nb, smem);
    xcd_barrier(xb);
    {
        const bool split = nb >= 256 && ((nb - 64) & 15) == 0;
        if (split) {
            if (bid < 64) { ph_hgrn(p, 256 + bid, smem); __syncthreads(); }
            else if (nb == 512) {
                const int b2 = bid - 64, wv_ = threadIdx.x >> 6;
                tr_loop(1280 + b2, NIT, 448);
                if (b2 < 128) { ph_rg_chain(p, 32 + (b2 >> 4), b2 & 15, smem); ph_cvt_tables(p, b2 * 4 + wv_, 128 * 4, smem, 0, 8192); }
                else {
                    const int c = b2 - 128;
                    ph_rg_chain(p, c >> 4, c & 15, smem);
                    if (c < 192) ph_rg_chain(p, (c + 320) >> 4, (c + 320) & 15, smem);
                    if (c < 128) { ph_hgrn(p, c, smem); __syncthreads(); ph_cvt_tables(p, c * 4 + wv_, 128 * 4, smem, 8192, 13312); }
                    else if (c < 192) ph_cvt_tables(p, (c - 128) * 4 + wv_, 64 * 4, smem, 13312, 20736);
                    else { ph_hgrn(p, c - 64, smem); __syncthreads(); ph_cvt_tables(p, (c - 192) * 4 + wv_, 128 * 4, smem, 20736, 2 * 16384); }
                }
            }
            else {
                const int b2 = bid - 64, nrest = nb - 64;
                for (int it = b2; it < 640; it += nrest) ph_rg_chain(p, it >> 4, it & 15, smem);
                for (int it = b2; it < 256; it += nrest) { ph_hgrn(p, it, smem); __syncthreads(); }
                if (nrest > 256) {
                    int xA = ((32768 + 256 * 58) / nrest - 58) & ~3; xA = xA < 0 ? 0 : xA;
                    const int rowsA = 256 * xA;
                    if (b2 < 256) ph_cvt_tables(p, b2 * 4 + (threadIdx.x >> 6), 256 * 4, smem, 0, rowsA);
                    else ph_cvt_tables(p, (b2 - 256) * 4 + (threadIdx.x >> 6), (nrest - 256) * 4, smem, rowsA, 2 * 16384);
                } else ph_cvt_tables(p, b2 * 4 + (threadIdx.x >> 6), nrest * 4, smem);
            }
        } else {
            for (int it = bid; it < 320; it += nb) { ph_hgrn(p, it, smem); __syncthreads(); }
            for (int it = bid; it < 640; it += nb) ph_rg_chain(p, it >> 4, it & 15, smem);
            ph_cvt_tables(p, bid * 4 + (threadIdx.x >> 6), nb * 4, smem);
        }
    }
    xcd_barrier(xb);
    if (grp) ph_combine(p, 64 * gg + gk, smem);
    else for (int it = bid; it < 512; it += nb) ph_combine(p, it, smem);
    if (grp) xcd_local_barrier(xb); else xcd_barrier(xb);
    gemm_phase<false, EPI3, 1>(p, (const u16*)(p.ws + OFF_MIX), DM, (const u16*)(p.ws + OFF_WOUT_T), DM, 8, vb, nb, smem);
    if (grp) xcd_local_barrier(xb); else xcd_barrier(xb);
    {
        const int tq = tid_opaque(), lane = tq & 63;
        const int it0 = grp ? 128 * gg + gk : bid, itS = grp ? 64 : nb, itE = grp ? 128 * (gg + 1) : NTOK / 16;
        u32x4 x[4][2], xn[4][2]; f32x4 lg[4], lbb[4];
        ln1_load(p, it0 < itE ? it0 : 0, tq, xn);
#pragma unroll
        for (int c = 0; c < 4; ++c) { lg[c] = *(const f32x4*)(p.ln1_g + lane * 16 + c * 4); lbb[c] = *(const f32x4*)(p.ln1_b + lane * 16 + c * 4); }
#pragma unroll 1
        for (int it = it0; it < itE; it += itS) {
#pragma unroll
            for (int u = 0; u < 4; ++u) { x[u][0] = xn[u][0]; x[u][1] = xn[u][1]; }
            ln1_load(p, it + itS < itE ? it + itS : it, tq, xn);
            ph_ln1stats(p, it, tq, x, lg, lbb);
        }
    }
    if (grp) xcd_local_barrier(xb); else xcd_barrier(xb);
    gemm_phase<true, EPI4, 1>(p, (const u16*)(p.ws + OFF_H2), DM, (const u16*)(p.ws + OFF_WQ_T), DM, 16, vb, nb, smem);
    if (grp) xcd_local_barrier(xb); else xcd_barrier(xb);
    {
        const int head = grp ? (gk & 7) : (bid & 7);
        const int nit = grp ? 4 : (2048 - bid + nb - 1) / nb;
        auto item_of = [&](int j) { return grp ? (32 * gg + (gk >> 3) + 8 * j) * 8 + head : bid + j * nb; };
        ph_topk_load_keys(p, head, smem);
        u32x4 qf[8];
        {
            const int t0 = threadIdx.x, lane = t0 & 63, wid = t0 >> 6;
            const u16* qrow = (const u16*)p.out + (size_t)((item_of(0) >> 3) * 64 + (wid & 1) * 32 + (lane & 31)) * 2048 + head * 256 + (wid >> 1) * 128 + (lane >> 5) * 8;
#pragma unroll
            for (int ks = 0; ks < 8; ++ks) qf[ks] = *(const u32x4*)(qrow + ks * 16);
        }
        __syncthreads();
        for (int j = 0; j < nit; ++j) ph_topk(p, item_of(j), item_of(j + 1 < nit ? j + 1 : j), qf, smem);
    }
    if (grp) xcd_local_barrier(xb); else xcd_barrier(xb);
    {
        const int it0 = grp ? 128 * gg + gk : bid, itS = grp ? 64 : nb, itE = grp ? 128 * (gg + 1) : NTOK / 16;
        for (int it = it0; it < itE; it += itS) ph_peer_out(p, it, smem);
    }
}

extern "C" void kernel_launch(void* const* d_in, const int* in_sizes, int n_in, void* d_out, int out_size, void* d_ws, size_t ws_size, hipStream_t stream) {
    P p{};
    const float** f = (const float**)&p;
    for (int i = 0; i < 27; ++i) f[i] = (const float*)d_in[i];
    p.out = (float*)d_out; p.ws = (char*)d_ws;
    static int grid_blocks = 0;
    if (!grid_blocks) {
        int dev = 0, cus = 0, per_cu = 0;
        (void)hipGetDevice(&dev);
        (void)hipDeviceGetAttribute(&cus, hipDeviceAttributeMultiprocessorCount, dev);
        (void)hipOccupancyMaxActiveBlocksPerMultiprocessor(&per_cu, mega, 256, 0);
        if (per_cu > 2) per_cu = 2;
        grid_blocks = cus * per_cu;
    }
    (void)hipMemsetAsync((char*)d_ws + OFF_BAR, 0, XCD_BAR_WORDS * 4, stream);
    void* args[] = {&p};
    hipError_t e = hipLaunchCooperativeKernel((void*)mega, dim3(grid_blocks), dim3(256), args, 0, stream);
    if (e != hipSuccess) fprintf(stderr, "cooperative launch failed: %s (grid %d)\n", hipGetErrorString(e), grid_blocks);
}
```
